# Optimizing an MI355X kernel written in HIP

```python
import jax
import jax.numpy as jnp
from jax import lax
import numpy as np


D_MODEL = 2048
BATCH = 4
SEQ = 4096
DEPTH = 4

HEAD_DIM = 128
ROPE_THETA = 500000.0
ROPE_DIM = HEAD_DIM // 4
N_MEM = 256
X_HEADS = 4
MOBA_HEADS = 8
MOBA_BLOCK = 256
MOBA_TOPK = 3
MOBA_QCHUNK = 32
NSA_HEADS = 8
NSA_GROUPS = 2
NSA_CMP_LEN = 32
NSA_CMP_STRIDE = 16
NSA_SEL_LEN = 64
NSA_TOPK = 16
NSA_WINDOW = 512
NSA_QCHUNK = 64
WIN_QBLOCK = 128
RET_HEADS = 8
RET_DK = 256
RET_DV = 512
RET_CHUNK = 128
RET_THETA = 10000.0
D_FF = 5632
CONV_WIDTH = 3
N_EVEN = (DEPTH + 1) // 2
N_ODD = DEPTH // 2
RMS_EPS = 1e-6
NEG = -1e30
FORCE = 1e9

AB_SIZES = (MOBA_HEADS * HEAD_DIM,) * 3 + (NSA_HEADS * HEAD_DIM,) + (NSA_GROUPS * HEAD_DIM,) * 6 + (NSA_HEADS * 3,)
AB_COLS = sum(AB_SIZES)
C_SIZES = (RET_HEADS * RET_DK,) * 2 + (RET_HEADS * RET_DV,) * 2
C_COLS = sum(C_SIZES)

kernel_name = 'hybrid_moba_nsa_retention_convffn'


def _split(t, sizes):
    out, start = [], 0
    for s in sizes:
        out.append(t[..., start:start + s])
        start += s
    return out


def _rmsnorm(x, g):
    xf = x.astype(jnp.float32)
    y = xf * lax.rsqrt(jnp.mean(jnp.square(xf), axis=-1, keepdims=True) + RMS_EPS)
    return (y * g.astype(jnp.float32)).astype(x.dtype)


def _heads(t, n):
    B, S, _ = t.shape
    return t.reshape(B, S, n, -1).transpose(0, 2, 1, 3)


def _merge(t):
    B, H, S, d = t.shape
    return t.transpose(0, 2, 1, 3).reshape(B, S, H * d)


def _rope(x, positions, rot_dim, theta):
    half = rot_dim // 2
    inv = jnp.float32(theta) ** (-jnp.arange(half, dtype=jnp.float32) / half)
    ang = positions.astype(jnp.float32)[:, None, :, None] * inv
    cos, sin = jnp.cos(ang), jnp.sin(ang)
    xr = x[..., :rot_dim].astype(jnp.float32)
    x1, x2 = xr[..., :half], xr[..., half:]
    rot = jnp.concatenate([x1 * cos - x2 * sin, x1 * sin + x2 * cos], axis=-1).astype(x.dtype)
    if rot_dim == x.shape[-1]:
        return rot
    return jnp.concatenate([rot, x[..., rot_dim:]], axis=-1)


def _moba(q, k, v):
    B, H, S, d = q.shape
    nb = -(-S // MOBA_BLOCK)
    sp = nb * MOBA_BLOCK
    pad = ((0, 0), (0, 0), (0, sp - S), (0, 0))
    q, k, v = jnp.pad(q, pad), jnp.pad(k, pad), jnp.pad(v, pad)
    kb = k.reshape(B, H, nb, MOBA_BLOCK, d)
    vb = v.reshape(B, H, nb, MOBA_BLOCK, d)
    kmean = jnp.mean(kb.astype(jnp.float32), axis=3)
    gate = jnp.einsum('bhsd,bhnd->bhsn', q.astype(jnp.float32), kmean)
    q_blk = jnp.arange(sp) // MOBA_BLOCK
    past = jnp.arange(nb)[None, :] < q_blk[:, None]
    gate = jnp.where(past, gate, NEG)
    kk = min(MOBA_TOPK, nb)
    g_val, g_idx = lax.top_k(gate, kk)
    g_ok = g_val > NEG / 2
    scale = d ** -0.5
    b_i = jnp.arange(B)[:, None, None, None]
    h_i = jnp.arange(H)[None, :, None, None]
    QC = MOBA_QCHUNK

    def chunk(c):
        s0 = c * QC
        qc = lax.dynamic_slice_in_dim(q, s0, QC, axis=2)
        idx = lax.dynamic_slice_in_dim(g_idx, s0, QC, axis=2)
        ok = lax.dynamic_slice_in_dim(g_ok, s0, QC, axis=2)
        k_sel = kb[b_i, h_i, idx]
        v_sel = vb[b_i, h_i, idx]
        own = s0 // MOBA_BLOCK
        k_own = lax.dynamic_index_in_dim(kb, own, axis=2, keepdims=False)
        v_own = lax.dynamic_index_in_dim(vb, own, axis=2, keepdims=False)
        s_sel = jnp.einsum('bhqd,bhqnkd->bhqnk', qc, k_sel).astype(jnp.float32) * scale
        s_sel = jnp.where(ok[..., None], s_sel, NEG).reshape(B, H, QC, kk * MOBA_BLOCK)
        s_own = jnp.einsum('bhqd,bhkd->bhqk', qc, k_own).astype(jnp.float32) * scale
        q_pos = s0 + jnp.arange(QC)
        k_pos = own * MOBA_BLOCK + jnp.arange(MOBA_BLOCK)
        s_own = jnp.where(k_pos[None, :] <= q_pos[:, None], s_own, NEG)
        p = jax.nn.softmax(jnp.concatenate([s_sel, s_own], axis=-1), axis=-1).astype(v.dtype)
        p_sel = p[..., :kk * MOBA_BLOCK].reshape(B, H, QC, kk, MOBA_BLOCK)
        p_own = p[..., kk * MOBA_BLOCK:]
        return (jnp.einsum('bhqnk,bhqnkd->bhqd', p_sel, v_sel)
                + jnp.einsum('bhqk,bhkd->bhqd', p_own, v_own))

    out = lax.map(chunk, jnp.arange(sp // QC))
    out = out.transpose(1, 2, 0, 3, 4).reshape(B, H, sp, d)
    return out[:, :, :S]


def _compress(t, pe, w1, w2):
    B, G, S, d = t.shape
    f = NSA_CMP_LEN // NSA_CMP_STRIDE
    n_sub = S // NSA_CMP_STRIDE
    n_cmp = n_sub - f + 1
    sub = t.reshape(B, G, n_sub, NSA_CMP_STRIDE, d)
    blocks = jnp.concatenate([sub[:, :, i:i + n_cmp] for i in range(f)], axis=3) + pe
    h = jax.nn.silu(blocks.reshape(B, G, n_cmp, NSA_CMP_LEN * d) @ w1)
    return h @ w2


def _nsa(q, k_c, v_c, k_s, v_s, k_w, v_w, gate_logits, positions, pe_k, w1_k, w2_k, pe_v, w1_v, w2_v):
    B, H, S, d = q.shape
    G = NSA_GROUPS
    R = H // G
    f32 = jnp.float32
    scale = d ** -0.5
    pos = jnp.arange(S)
    kc = _compress(k_c, pe_k, w1_k, w2_k)
    vc = _compress(v_c, pe_v, w1_v, w2_v)
    n_cmp = kc.shape[2]
    qg = q.reshape(B, G, R, S, d)
    s_c = jnp.einsum('bgrsd,bgnd->bgrsn', qg, kc).astype(f32) * scale
    c_ok = (jnp.arange(n_cmp) * NSA_CMP_STRIDE + NSA_CMP_LEN - 1)[None, :] <= pos[:, None]
    p_c = jnp.where(c_ok, jax.nn.softmax(jnp.where(c_ok, s_c, NEG), axis=-1), 0.0)
    o_c = jnp.einsum('bgrsn,bgnd->bgrsd', p_c.astype(vc.dtype), vc)
    n_sel = S // NSA_SEL_LEN
    c_start = np.arange(n_cmp) * NSA_CMP_STRIDE
    s_start = np.arange(n_sel) * NSA_SEL_LEN
    cover = (c_start[:, None] < s_start[None, :] + NSA_SEL_LEN) & (c_start[:, None] + NSA_CMP_LEN > s_start[None, :])
    imp = jnp.einsum('bgrsn,nj->bgsj', p_c, jnp.asarray(cover, f32))
    blk = pos // NSA_SEL_LEN
    j = jnp.arange(n_sel)
    forced = (j[None, :] == 0) | (j[None, :] == blk[:, None]) | (j[None, :] == blk[:, None] - 1)
    imp = jnp.where(forced, FORCE, jnp.where(j[None, :] <= blk[:, None], imp, NEG))
    kk = min(NSA_TOPK, n_sel)
    s_val, s_idx = lax.top_k(imp, kk)
    s_ok = s_val > NEG / 2
    q_rot = _rope(q, positions, ROPE_DIM, ROPE_THETA).reshape(B, G, R, S, d)
    k_s = _rope(k_s, positions, ROPE_DIM, ROPE_THETA)
    k_w = _rope(k_w, positions, ROPE_DIM, ROPE_THETA)
    ksb = k_s.reshape(B, G, n_sel, NSA_SEL_LEN, d)
    vsb = v_s.reshape(B, G, n_sel, NSA_SEL_LEN, d)
    b_i = jnp.arange(B)[:, None, None, None]
    g_i = jnp.arange(G)[None, :, None, None]
    QC = NSA_QCHUNK

    def chunk(c):
        s0 = c * QC
        qc = lax.dynamic_slice_in_dim(q_rot, s0, QC, axis=3)
        idx = lax.dynamic_slice_in_dim(s_idx, s0, QC, axis=2)
        ok = lax.dynamic_slice_in_dim(s_ok, s0, QC, axis=2)
        k_sel = ksb[b_i, g_i, idx]
        v_sel = vsb[b_i, g_i, idx]
        sc = jnp.einsum('bgrqd,bgqnkd->bgrqnk', qc, k_sel).astype(f32) * scale
        k_pos = idx[..., None] * NSA_SEL_LEN + jnp.arange(NSA_SEL_LEN)
        q_pos = s0 + jnp.arange(QC)
        valid = ok[..., None] & (k_pos <= q_pos[:, None, None])
        sc = jnp.where(valid[:, :, None], sc, NEG).reshape(B, G, R, QC, kk * NSA_SEL_LEN)
        p = jax.nn.softmax(sc, axis=-1).astype(v_sel.dtype).reshape(B, G, R, QC, kk, NSA_SEL_LEN)
        return jnp.einsum('bgrqnk,bgqnkd->bgrqd', p, v_sel)

    o_s = lax.map(chunk, jnp.arange(S // QC))
    o_s = o_s.transpose(1, 2, 3, 0, 4, 5).reshape(B, G, R, S, d)
    nqb = S // WIN_QBLOCK
    span = NSA_WINDOW + WIN_QBLOCK
    kv_idx = jnp.arange(nqb)[:, None] * WIN_QBLOCK + jnp.arange(span)[None, :]
    padw = ((0, 0), (0, 0), (NSA_WINDOW, 0), (0, 0))
    k_win = jnp.pad(k_w, padw)[:, :, kv_idx]
    v_win = jnp.pad(v_w, padw)[:, :, kv_idx]
    qb = q_rot.reshape(B, G, R, nqb, WIN_QBLOCK, d)
    sw = jnp.einsum('bgrcqd,bgckd->bgrcqk', qb, k_win).astype(f32) * scale
    q_pos = pos.reshape(nqb, WIN_QBLOCK)
    k_pos = kv_idx - NSA_WINDOW
    dist = q_pos[:, :, None] - k_pos[:, None, :]
    w_ok = (dist >= 0) & (dist < NSA_WINDOW) & (k_pos[:, None, :] >= 0)
    p_w = jax.nn.softmax(jnp.where(w_ok, sw, NEG), axis=-1).astype(v_win.dtype)
    o_w = jnp.einsum('bgrcqk,bgckd->bgrcqd', p_w, v_win).reshape(B, G, R, S, d)
    gates = jax.nn.sigmoid(gate_logits.astype(f32)).reshape(B, S, H, 3).transpose(0, 2, 1, 3).reshape(B, G, R, S, 3)
    o = gates[..., 0:1] * o_c + gates[..., 1:2] * o_s + gates[..., 2:3] * o_w
    return o.reshape(B, H, S, d).astype(q.dtype)


def _mixer_ab(h, positions, w_in, pe_k, w1_k, w2_k, pe_v, w1_v, w2_v, w_out):
    mq, mk, mv, nq, nkc, nvc, nks, nvs, nkw, nvw, ng = _split(h @ w_in, AB_SIZES)
    mq = _rope(_heads(mq, MOBA_HEADS), positions, ROPE_DIM, ROPE_THETA)
    mk = _rope(_heads(mk, MOBA_HEADS), positions, ROPE_DIM, ROPE_THETA)
    o_a = _moba(mq, mk, _heads(mv, MOBA_HEADS))
    o_b = _nsa(_heads(nq, NSA_HEADS), _heads(nkc, NSA_GROUPS), _heads(nvc, NSA_GROUPS),
               _heads(nks, NSA_GROUPS), _heads(nvs, NSA_GROUPS), _heads(nkw, NSA_GROUPS),
               _heads(nvw, NSA_GROUPS), ng, positions, pe_k, w1_k, w2_k, pe_v, w1_v, w2_v)
    o = jnp.concatenate([o_a, o_b.astype(o_a.dtype)], axis=1)
    return _merge(o) @ w_out


def _retention(q, k, v):
    B, H, S, dk = q.shape
    dv = v.shape[-1]
    C = RET_CHUNK
    nch = S // C
    log_g = jnp.log(1.0 - jnp.exp2(-5.0 - jnp.arange(H, dtype=jnp.float32)))
    n = jnp.arange(C, dtype=jnp.float32)
    diff = n[:, None] - n[None, :]
    decay = jnp.where(diff >= 0, jnp.exp(jnp.maximum(diff, 0.0) * log_g[:, None, None]), 0.0)
    q_dec = jnp.exp((n + 1.0) * log_g[:, None])[:, :, None]
    k_dec = jnp.exp((C - 1.0 - n) * log_g[:, None])[:, :, None]
    c_dec = jnp.exp(C * log_g)[:, None, None]

    def to_chunks(t):
        return t.reshape(B, H, nch, C, t.shape[-1]).transpose(2, 0, 1, 3, 4)

    def step(state, xs):
        qi, ki, vi = xs
        intra = jnp.einsum('bhnm,bhmv->bhnv', jnp.einsum('bhnd,bhmd->bhnm', qi, ki) * decay, vi)
        cross = jnp.einsum('bhnd,bhdv->bhnv', qi, state) * q_dec
        state = state * c_dec + jnp.einsum('bhmd,bhmv->bhdv', ki * k_dec, vi)
        return state, intra + cross

    state0 = jnp.zeros((B, H, dk, dv), jnp.float32)
    _, out = lax.scan(step, state0, (to_chunks(q), to_chunks(k), to_chunks(v)))
    return out.transpose(1, 2, 0, 3, 4).reshape(B, H, S, dv)


def _mixer_c(h, positions, w_in, gn_gain, w_out):
    f32 = jnp.float32
    q, k, v, g = _split(h @ w_in, C_SIZES)
    q = _rope(_heads(q, RET_HEADS), positions, RET_DK, RET_THETA).astype(f32)
    k = _rope(_heads(k, RET_HEADS), positions, RET_DK, RET_THETA).astype(f32) * RET_DK ** -0.5
    v = _heads(v, RET_HEADS).astype(f32)
    y = _retention(q, k, v)
    mu = jnp.mean(y, axis=-1, keepdims=True)
    var = jnp.mean(jnp.square(y - mu), axis=-1, keepdims=True)
    y = (y - mu) * lax.rsqrt(var + RMS_EPS) * gn_gain.astype(f32)[None, :, None, :]
    y = _merge(y).astype(h.dtype)
    return (jax.nn.silu(g) * y) @ w_out


def _cross_attn(h, mem_n, w_q, w_kv, w_o):
    q = _heads(h @ w_q, X_HEADS)
    k, v = _split(mem_n @ w_kv, (X_HEADS * HEAD_DIM, X_HEADS * HEAD_DIM))
    k, v = _heads(k, X_HEADS), _heads(v, X_HEADS)
    s = jnp.einsum('bhsd,bhmd->bhsm', q, k).astype(jnp.float32) * HEAD_DIM ** -0.5
    p = jax.nn.softmax(s, axis=-1).astype(v.dtype)
    return _merge(jnp.einsum('bhsm,bhmd->bhsd', p, v)) @ w_o


def _conv_ffn(h, w_up, conv_w, conv_b, w_down):
    S = h.shape[1]
    u = h @ w_up
    up = jnp.pad(u, ((0, 0), (CONV_WIDTH - 1, 0), (0, 0)))
    c = conv_b + sum(conv_w[i] * up[:, i:i + S] for i in range(CONV_WIDTH))
    gate, val = _split(c, (D_FF, D_FF))
    return (jax.nn.silu(gate) * val) @ w_down


def setup_inputs(seed: int = 0) -> dict:
    key = jax.random.key(seed)
    ks = jax.random.split(key, 26)
    f32 = jnp.float32

    def nrm(k, shape, scale):
        return jax.random.normal(k, shape, f32) * scale

    def gain(k, shape):
        return 1.0 + nrm(k, shape, 0.02)

    D = D_MODEL
    positions = (jax.random.randint(ks[2], (BATCH, 1), 0, 1024, dtype=jnp.int32)
                 + jnp.arange(SEQ, dtype=jnp.int32)[None, :])
    return {
        'x': nrm(ks[0], (BATCH, SEQ, D), 1.0),
        'mem': nrm(ks[1], (BATCH, N_MEM, D), 1.0),
        'positions': positions,
        'norm_mix': gain(ks[3], (DEPTH, D)),
        'norm_cross': gain(ks[4], (DEPTH, D)),
        'norm_ffn': gain(ks[5], (DEPTH, D)),
        'norm_mem': gain(ks[6], (D,)),
        'norm_final': gain(ks[7], (D,)),
        'w_in_ab': nrm(ks[8], (N_EVEN, D, AB_COLS), D ** -0.5),
        'cmp_pe_k': nrm(ks[9], (N_EVEN, NSA_CMP_LEN, HEAD_DIM), 0.1),
        'cmp_w1_k': nrm(ks[10], (N_EVEN, NSA_CMP_LEN * HEAD_DIM, HEAD_DIM), (NSA_CMP_LEN * HEAD_DIM) ** -0.5),
        'cmp_w2_k': nrm(ks[11], (N_EVEN, HEAD_DIM, HEAD_DIM), HEAD_DIM ** -0.5),
        'cmp_pe_v': nrm(ks[12], (N_EVEN, NSA_CMP_LEN, HEAD_DIM), 0.1),
        'cmp_w1_v': nrm(ks[13], (N_EVEN, NSA_CMP_LEN * HEAD_DIM, HEAD_DIM), (NSA_CMP_LEN * HEAD_DIM) ** -0.5),
        'cmp_w2_v': nrm(ks[14], (N_EVEN, HEAD_DIM, HEAD_DIM), HEAD_DIM ** -0.5),
        'w_out_ab': nrm(ks[15], (N_EVEN, D, D), D ** -0.5),
        'w_in_c': nrm(ks[16], (N_ODD, D, C_COLS), D ** -0.5),
        'ret_gn': gain(ks[17], (N_ODD, RET_HEADS, RET_DV)),
        'w_out_c': nrm(ks[18], (N_ODD, RET_HEADS * RET_DV, D), (RET_HEADS * RET_DV) ** -0.5),
        'w_q_x': nrm(ks[19], (DEPTH, D, X_HEADS * HEAD_DIM), D ** -0.5),
        'w_kv_x': nrm(ks[20], (DEPTH, D, 2 * X_HEADS * HEAD_DIM), D ** -0.5),
        'w_o_x': nrm(ks[21], (DEPTH, X_HEADS * HEAD_DIM, D), (X_HEADS * HEAD_DIM) ** -0.5),
        'w_up': nrm(ks[22], (DEPTH, D, 2 * D_FF), D ** -0.5),
        'conv_w': nrm(ks[23], (DEPTH, CONV_WIDTH, 2 * D_FF), CONV_WIDTH ** -0.5),
        'conv_b': nrm(ks[24], (DEPTH, 2 * D_FF), 0.02),
        'w_down': nrm(ks[25], (DEPTH, D_FF, D), D_FF ** -0.5),
    }


def reference(x, mem, positions, norm_mix, norm_cross, norm_ffn, norm_mem, norm_final,
              w_in_ab, cmp_pe_k, cmp_w1_k, cmp_w2_k, cmp_pe_v, cmp_w1_v, cmp_w2_v, w_out_ab,
              w_in_c, ret_gn, w_out_c, w_q_x, w_kv_x, w_o_x, w_up, conv_w, conv_b, w_down):
    mem_n = _rmsnorm(mem, norm_mem)
    h = x
    for l in range(DEPTH):
        hn = _rmsnorm(h, norm_mix[l])
        if l % 2 == 0:
            e = l // 2
            h = h + _mixer_ab(hn, positions, w_in_ab[e], cmp_pe_k[e], cmp_w1_k[e], cmp_w2_k[e],
                              cmp_pe_v[e], cmp_w1_v[e], cmp_w2_v[e], w_out_ab[e])
        else:
            o = l // 2
            h = h + _mixer_c(hn, positions, w_in_c[o], ret_gn[o], w_out_c[o])
        h = h + _cross_attn(_rmsnorm(h, norm_cross[l]), mem_n, w_q_x[l], w_kv_x[l], w_o_x[l])
        h = h + _conv_ffn(_rmsnorm(h, norm_ffn[l]), w_up[l], conv_w[l], conv_b[l], w_down[l])
    return _rmsnorm(h, norm_final)
```

```cpp
#include <hip/hip_runtime.h>
#include <cstdio>
#include <cstdint>
namespace pg8 {
#define PG8_LAS __attribute__((address_space(3)))
typedef unsigned short bf16_t;
typedef short bf16x8 __attribute__((ext_vector_type(8)));
typedef float f32x4 __attribute__((ext_vector_type(4)));
typedef unsigned u32x4 __attribute__((ext_vector_type(4)));
constexpr int BM = 256, BK = 64, HALF = 128, HTB = HALF * BK * 2  , STAGE_BYTES = 8 * HTB, NXCD = 8, WGM = 8;

__host__ __device__ __forceinline__ int lds_byte(int r, int c) { const int st = (r >> 4) * 2 + (c >> 5), rr = r & 15, cc = c & 31, ob = rr * 64 + cc * 2; return st * 1024 + (ob ^ (((ob >> 9) & 1) << 5)); }
__host__ __device__ __forceinline__ void stage_rc(int b, int& R, int& C) { const int st = b / 1024, sb = b % 1024, swz = sb ^ (((sb >> 9) & 1) << 5); R = (st >> 1) * 16 + swz / 64; C = (st & 1) * 32 + (swz % 64) / 2; }
__host__ __device__ __forceinline__ int perm32(int rho) { const int n = rho >> 4, i = rho & 15; return 8 * (i >> 2) + 4 * n + (i & 3); }

struct Unit { int pm, pn; };
struct Gemm { const bf16_t* A; const bf16_t* Bt; int M, N, K; };

struct StaticOrder {
    int nM, nN, nwg, G, c;
    __host__ __device__ void init(int M, int N, int G_, int c_) { nM = M / BM; nN = N / BM; nwg = nM * nN; G = G_; c = c_; }
    __host__ __device__ bool next(int i, Unit& u) const {
        const long L = (long)i * G + c; if (L >= nwg) return false;
        int wgid = (int)L; { const int q = nwg / NXCD, r = nwg % NXCD, xcd = wgid % NXCD, off = wgid / NXCD; wgid = (xcd < r ? xcd * (q + 1) : r * (q + 1) + (xcd - r) * q) + off; }
        const int nig = WGM * nN, gid = wgid / nig, fm = gid * WGM, gsz = (nM - fm) < WGM ? (nM - fm) : WGM;
        u.pm = fm + ((wgid % nig) % gsz); u.pn = (wgid % nig) / gsz; return true;
    }
    __device__ __forceinline__ void a_ready(const Unit&) const {}
    __device__ __forceinline__ void done(const Unit&) const {}
};
typedef __bf16 bf16x2_native __attribute__((ext_vector_type(2)));
__device__ __forceinline__ unsigned cvt_pk_bf16(float lo, float hi) { bf16x2_native v; v.x = (__bf16)lo; v.y = (__bf16)hi; return __builtin_bit_cast(unsigned, v); }
struct EpiStore {
    static constexpr bool PERM = true, AFTER_DRAIN = false, PERMA = false;
    bf16_t* O; int ldc;
    __device__ __forceinline__ void operator()(const f32x4 (&acc)[2][2][4][2], const Unit& u, int wr, int wc, int fr, int fq) const {
        const int row0 = u.pm * BM + wr * 64 + fr, col0 = u.pn * BM + wc * 32 + 8 * fq;
#pragma unroll
        for (int ai = 0; ai < 2; ++ai)
#pragma unroll
            for (int m = 0; m < 4; ++m) { bf16_t* rowp = O + (size_t)(row0 + ai * HALF + m * 16) * ldc + col0;
#pragma unroll
                for (int bj = 0; bj < 2; ++bj) { const f32x4 v0 = acc[ai][bj][m][0], v1 = acc[ai][bj][m][1];
                    u32x4 w; w.x = cvt_pk_bf16(v0[0], v0[1]); w.y = cvt_pk_bf16(v0[2], v0[3]); w.z = cvt_pk_bf16(v1[0], v1[1]); w.w = cvt_pk_bf16(v1[2], v1[3]);
                    *(u32x4*)(rowp + bj * HALF) = w; } }
    }
};
__device__ __forceinline__ float epi_x16(float v) { return __int_as_float(__builtin_amdgcn_ds_swizzle(__float_as_int(v), (16 << 10) | 0x1F)); }
__device__ __forceinline__ float epi_x32sum(float v) { auto rr = __builtin_amdgcn_permlane32_swap(__float_as_uint(v), __float_as_uint(v), false, false); return __uint_as_float(rr[0]) + __uint_as_float(rr[1]); }
struct EpiStoreN {
    static constexpr bool PERM = true, AFTER_DRAIN = false, PERMA = false;
    bf16_t* O; int ldc; const float* SSP; int Mrows; const int* positions; int rope_mode; bf16_t* O2;
    __device__ __forceinline__ void operator()(const f32x4 (&acc)[2][2][4][2], const Unit& u, int wr, int wc, int fr, int fq) const {
        const int row0 = u.pm * BM + wr * 64 + fr, col0 = u.pn * BM + wc * 32 + 8 * fq;
        const bool rope1 = (rope_mode == 1) && (u.pn < 16);
        const bool nq = (rope_mode == 2) && (u.pn >= 12) && (u.pn < 16);
        const bool rope2t = (rope_mode == 2) && ((u.pn < 8) || nq || (u.pn == 18) || (u.pn == 20));
        const bool rope2 = rope2t && (wc == 0);
        const float ksc = (rope1 && u.pn >= 8) ? 0.0625f : 1.0f;
        float inv[2][4];
        if (rope1) {
#pragma unroll
            for (int n = 0; n < 2; ++n)
#pragma unroll
                for (int j = 0; j < 4; ++j) inv[n][j] = exp2f(-(float)(wc * 32 + 8 * fq + 4 * n + j) * (13.287712379549449f / 128.0f)) * 0.15915494309189535f;
        } else if (rope2) {
#pragma unroll
            for (int n = 0; n < 2; ++n)
#pragma unroll
                for (int j = 0; j < 4; ++j) inv[n][j] = exp2f(-(float)(8 * (fq & 1) + 4 * n + j) * (18.931568569324174f / 16.0f)) * 0.15915494309189535f;
        }
        float spa[2][4], spb[2][4]; int posi[2][4];
        const int* pp = (rope1 || rope2) ? positions : (const int*)SSP;
#pragma unroll
        for (int ai = 0; ai < 2; ++ai)
#pragma unroll
            for (int m = 0; m < 4; ++m) { const int row = row0 + ai * HALF + m * 16;
                spa[ai][m] = SSP[(size_t)(2 * fq) * Mrows + row]; spb[ai][m] = SSP[(size_t)(2 * fq + 1) * Mrows + row];
                posi[ai][m] = pp[row]; }
        asm volatile("" ::: "memory");
        float sp[2][4], posf[2][4];
#pragma unroll
        for (int ai = 0; ai < 2; ++ai)
#pragma unroll
            for (int m = 0; m < 4; ++m) { sp[ai][m] = spa[ai][m] + spb[ai][m]; posf[ai][m] = (float)posi[ai][m]; }
#pragma unroll
        for (int ai = 0; ai < 2; ++ai)
#pragma unroll
            for (int m = 0; m < 4; ++m) { const int row = row0 + ai * HALF + m * 16;
                float s = sp[ai][m];
                s += epi_x16(s); s = epi_x32sum(s);
                const float rstd = __builtin_amdgcn_rsqf(s * (1.0f / 2048.0f) + 1e-6f) * ksc;
                f32x4 v[2][2];
#pragma unroll
                for (int bj = 0; bj < 2; ++bj)
#pragma unroll
                    for (int n = 0; n < 2; ++n) v[bj][n] = acc[ai][bj][m][n] * rstd;
                bf16_t* rowp = O + (size_t)row * ldc + col0;
                if (nq) {
#pragma unroll
                    for (int bj = 0; bj < 2; ++bj) { u32x4 w; w.x = cvt_pk_bf16(v[bj][0][0], v[bj][0][1]); w.y = cvt_pk_bf16(v[bj][0][2], v[bj][0][3]); w.z = cvt_pk_bf16(v[bj][1][0], v[bj][1][1]); w.w = cvt_pk_bf16(v[bj][1][2], v[bj][1][3]);
                        *(u32x4*)(rowp + bj * HALF) = w; }
                    rowp = O2 + (size_t)row * 1024 + (u.pn - 12) * BM + wc * 32 + 8 * fq;
                }
                if (rope1) { const float pos = posf[ai][m];
#pragma unroll
                    for (int n = 0; n < 2; ++n)
#pragma unroll
                        for (int j = 0; j < 4; ++j) { const float rev = __builtin_amdgcn_fractf(pos * inv[n][j]);
                            const float sn = __builtin_amdgcn_sinf(rev), cs = __builtin_amdgcn_cosf(rev);
                            const float x1 = v[0][n][j], x2 = v[1][n][j]; v[0][n][j] = x1 * cs - x2 * sn; v[1][n][j] = x1 * sn + x2 * cs; } }
                if (rope2) {
                    const float pos = posf[ai][m];
#pragma unroll
                    for (int bj = 0; bj < 2; ++bj)
#pragma unroll
                        for (int n = 0; n < 2; ++n)
#pragma unroll
                            for (int j = 0; j < 4; ++j) { const float x = v[bj][n][j];
                                auto rr = __builtin_amdgcn_permlane32_swap(__float_as_uint(x), __float_as_uint(x), false, false);
                                const float px = __uint_as_float(fq >= 2 ? rr[0] : rr[1]);
                                const float rev = __builtin_amdgcn_fractf(pos * inv[n][j]); const float sn = __builtin_amdgcn_sinf(rev), cs = __builtin_amdgcn_cosf(rev);
                                v[bj][n][j] = (fq < 2) ? (x * cs - px * sn) : (px * sn + x * cs); } }
#pragma unroll
                for (int bj = 0; bj < 2; ++bj) { u32x4 w; w.x = cvt_pk_bf16(v[bj][0][0], v[bj][0][1]); w.y = cvt_pk_bf16(v[bj][0][2], v[bj][0][3]); w.z = cvt_pk_bf16(v[bj][1][0], v[bj][1][1]); w.w = cvt_pk_bf16(v[bj][1][2], v[bj][1][3]);
                    *(u32x4*)(rowp + bj * HALF) = w; } }
    }
};
struct EpiResid3 {
    static constexpr bool PERM = true, AFTER_DRAIN = false, PERMA = false;
    bf16_t* HB; float* SSP; int Mrows; PG8_LAS float* scr; int ldc;
    __device__ __forceinline__ void operator()(const f32x4 (&acc)[2][2][4][2], const Unit& u, int wr, int wc, int fr, int fq) const {
        const int row0 = u.pm * BM + wr * 64 + fr, col0 = u.pn * BM + wc * 32 + 8 * fq;
        u32x4 old[2][4][2];
#pragma unroll
        for (int ai = 0; ai < 2; ++ai)
#pragma unroll
            for (int m = 0; m < 4; ++m)
#pragma unroll
                for (int bj = 0; bj < 2; ++bj) old[ai][m][bj] = *(const u32x4*)(HB + (size_t)(row0 + ai * HALF + m * 16) * ldc + col0 + bj * HALF);
#pragma unroll
        for (int ai = 0; ai < 2; ++ai)
#pragma unroll
            for (int m = 0; m < 4; ++m) { bf16_t* rowp = HB + (size_t)(row0 + ai * HALF + m * 16) * ldc + col0; float ss = 0.f;
#pragma unroll
                for (int bj = 0; bj < 2; ++bj) { const u32x4 o4 = old[ai][m][bj];
                    const f32x4 a0 = acc[ai][bj][m][0], a1 = acc[ai][bj][m][1];
                    const float h0 = __uint_as_float(o4.x << 16) + a0[0], h1 = __uint_as_float(o4.x & 0xffff0000u) + a0[1], h2 = __uint_as_float(o4.y << 16) + a0[2], h3 = __uint_as_float(o4.y & 0xffff0000u) + a0[3];
                    const float h4 = __uint_as_float(o4.z << 16) + a1[0], h5 = __uint_as_float(o4.z & 0xffff0000u) + a1[1], h6 = __uint_as_float(o4.w << 16) + a1[2], h7 = __uint_as_float(o4.w & 0xffff0000u) + a1[3];
                    u32x4 w; w.x = cvt_pk_bf16(h0, h1); w.y = cvt_pk_bf16(h2, h3); w.z = cvt_pk_bf16(h4, h5); w.w = cvt_pk_bf16(h6, h7);
                    *(u32x4*)(rowp + bj * HALF) = w;
                    ss += ((h0 * h0 + h1 * h1) + (h2 * h2 + h3 * h3)) + ((h4 * h4 + h5 * h5) + (h6 * h6 + h7 * h7)); }
                ss += epi_x16(ss); ss = epi_x32sum(ss);
                if (fq == 0) scr[(ai * HALF + wr * 64 + m * 16 + fr) * 4 + wc] = ss; }
        asm volatile("s_waitcnt lgkmcnt(0)" ::: "memory"); __builtin_amdgcn_s_barrier(); asm volatile("" ::: "memory");
        const int t = (wr * 4 + wc) * 64 + fq * 16 + fr;
        if (t < 256) { const f32x4 p = *(const PG8_LAS f32x4*)(scr + t * 4); SSP[(size_t)u.pn * Mrows + u.pm * BM + t] = (p[0] + p[1]) + (p[2] + p[3]); }
    }
};

#define DPPF(old, src, CTRL) __int_as_float(__builtin_amdgcn_update_dpp(__float_as_int(old), __float_as_int(src), (CTRL), 0xf, 0xf, false))
#define DPPR(src, CTRL) __int_as_float(__builtin_amdgcn_mov_dpp(__float_as_int(src), (CTRL), 0xf, 0xf, true))
struct EpiStoreFFN {
    static constexpr bool PERM = true, AFTER_DRAIN = false, PERMA = true;
    bf16_t* ACT; const float* SSP; int Mrows; const float* cw  ; const float* cb  ; bf16_t* UH  ; PG8_LAS float* scr  ;
    __device__ __forceinline__ void operator()(const f32x4 (&acc)[2][2][4][2], const Unit& u, int wr, int wc, int fr_in, int fq_in) const {
        constexpr int DFFc = 5632, DFF2c = 11264;
        int z_ = 0; asm volatile("" : "+v"(z_)); const int lane_ = (int)__builtin_amdgcn_mbcnt_hi(~0u, __builtin_amdgcn_mbcnt_lo(~0u, (unsigned)z_));
        const int fr = lane_ & 15, fq = lane_ >> 4; (void)fr_in; (void)fq_in;
        const int row0 = u.pm * BM + wr * 64 + 4 * fr;
        const int g0 = u.pn * 128 + wc * 32 + 8 * fq;
        PG8_LAS float* RT = scr + 2048;
        const int t = (wr * 4 + wc) * 64 + fq * 16 + fr;
        float sp_[8], cw0 = 0.f, cw1 = 0.f, cw2 = 0.f, cb0 = 0.f;
        if (t < 256) { const size_t row = (size_t)u.pm * BM + t;
#pragma unroll
            for (int j = 0; j < 8; ++j) sp_[j] = SSP[(size_t)j * Mrows + row];
            const int gc = (t < 128) ? (u.pn * 128 + t) : (DFFc + u.pn * 128 + (t - 128));
            cw0 = cw[gc]; cw1 = cw[DFF2c + gc]; cw2 = cw[2 * DFF2c + gc]; cb0 = cb[gc]; }
        const int wslot = (wr * 4 + wc) * 2;
        typedef unsigned u32x2e __attribute__((ext_vector_type(2)));
        if (fr == 15) {
#pragma unroll
            for (int ai = 0; ai < 2; ++ai)
#pragma unroll
                for (int bj = 0; bj < 2; ++bj)
#pragma unroll
                    for (int n = 0; n < 2; ++n)
#pragma unroll
                        for (int mm = 2; mm < 4; ++mm) *(PG8_LAS f32x4*)(scr + (((wslot + ai) * 2 + (mm - 2)) * 64 + bj * 32 + 8 * fq + 4 * n)) = acc[ai][bj][mm][n];
        }
        if (t < 256) { float s_ = 0.f;
#pragma unroll
            for (int j = 0; j < 8; ++j) s_ += sp_[j];
            RT[t] = __builtin_amdgcn_rsqf(s_ * (1.0f / 2048.0f) + 1e-6f);
            scr[2304 + t] = cw0; scr[2304 + 256 + t] = cw1; scr[2304 + 512 + t] = cw2; scr[2304 + 768 + t] = cb0;
            scr[3328 + t] = 0.f; scr[3328 + 256 + t] = 0.f; }
        asm volatile("s_waitcnt lgkmcnt(0)" ::: "memory"); __builtin_amdgcn_s_barrier(); asm volatile("" ::: "memory");
        auto rstd4 = [&](int ai) { return *(const PG8_LAS f32x4*)(RT + ai * HALF + wr * 64 + 4 * fr); };
        if (wr == 1 && fr == 15) { const f32x4 rs4 = rstd4(1);
#pragma unroll
            for (int bj = 0; bj < 2; ++bj)
#pragma unroll
                for (int n = 0; n < 2; ++n)
#pragma unroll
                    for (int mm = 2; mm < 4; ++mm) { const f32x4 x = acc[1][bj][mm][n] * rs4[mm]; bf16_t* p = UH + ((size_t)u.pm * 4 + mm) * DFF2c + bj * DFFc + g0 + 4 * n;
                        u32x2e w; w.x = cvt_pk_bf16(x[0], x[1]); w.y = cvt_pk_bf16(x[2], x[3]); *(u32x2e*)p = w; }
        }
        if (wr == 0 && fr == 0) { const f32x4 rs4 = rstd4(0);
#pragma unroll
            for (int bj = 0; bj < 2; ++bj)
#pragma unroll
                for (int n = 0; n < 2; ++n)
#pragma unroll
                    for (int mm = 0; mm < 2; ++mm) { const f32x4 x = acc[0][bj][mm][n] * rs4[mm]; bf16_t* p = UH + ((size_t)u.pm * 4 + mm) * DFF2c + bj * DFFc + g0 + 4 * n;
                        u32x2e w; w.x = cvt_pk_bf16(x[0], x[1]); w.y = cvt_pk_bf16(x[2], x[3]); *(u32x2e*)p = w; }
        }
#pragma unroll
        for (int n = 0; n < 2; ++n) {
            f32x4 wg[3], wv[3], bg, bv;
            { const PG8_LAS float* WT = scr + 2304 + wc * 32 + 8 * fq + 4 * n;
#pragma unroll
              for (int i = 0; i < 3; ++i) { wg[i] = *(const PG8_LAS f32x4*)(WT + i * 256); wv[i] = *(const PG8_LAS f32x4*)(WT + i * 256 + 128); }
              bg = *(const PG8_LAS f32x4*)(WT + 768); bv = *(const PG8_LAS f32x4*)(WT + 768 + 128); }
#pragma unroll
            for (int ai = 0; ai < 2; ++ai) {
                const bool have = !(wr == 0 && ai == 0);
                const int src = (wr == 1) ? ((0 * 4 + wc) * 2 + ai) : ((1 * 4 + wc) * 2 + 0);
                const int hb = (have ? src * 128 : 3328 + wc * 128) + 8 * fq + 4 * n, rb = have ? ai * HALF + wr * 64 - 2 : 0;
                const float r14 = RT[rb], r15 = RT[rb + 1];
                const f32x4 hg14 = *(const PG8_LAS f32x4*)(scr + hb) * r14, hg15 = *(const PG8_LAS f32x4*)(scr + hb + 64) * r15;
                const f32x4 hv14 = *(const PG8_LAS f32x4*)(scr + hb + 32) * r14, hv15 = *(const PG8_LAS f32x4*)(scr + hb + 64 + 32) * r15;
                const f32x4 rs4 = rstd4(ai);
                f32x4 xg[4], xv[4];
#pragma unroll
                for (int m = 0; m < 4; ++m) { xg[m] = acc[ai][0][m][n] * rs4[m]; xv[m] = acc[ai][1][m][n] * rs4[m]; }
                f32x4 g1, g2, v1, v2;
#pragma unroll
                for (int j = 0; j < 4; ++j) { g1[j] = DPPF(hg15[j], xg[3][j], 0x111); g2[j] = DPPF(hg14[j], xg[2][j], 0x111); v1[j] = DPPF(hv15[j], xv[3][j], 0x111); v2[j] = DPPF(hv14[j], xv[2][j], 0x111); }
#pragma unroll
                for (int m = 0; m < 4; ++m) {
                    const f32x4 pg1 = (m == 0) ? g1 : xg[m - 1], pg2 = (m == 0) ? g2 : ((m == 1) ? g1 : xg[m - 2]);
                    const f32x4 pv1 = (m == 0) ? v1 : xv[m - 1], pv2 = (m == 0) ? v2 : ((m == 1) ? v1 : xv[m - 2]);
                    const f32x4 cg = bg + wg[2] * xg[m] + wg[1] * pg1 + wg[0] * pg2, cv = bv + wv[2] * xv[m] + wv[1] * pv1 + wv[0] * pv2;
                    f32x4 a;
#pragma unroll
                    for (int j = 0; j < 4; ++j) a[j] = cg[j] * __builtin_amdgcn_rcpf(1.0f + __builtin_amdgcn_exp2f(-1.4426950408889634f * cg[j])) * cv[j];
                    { u32x2e w; w.x = cvt_pk_bf16(a[0], a[1]); w.y = cvt_pk_bf16(a[2], a[3]);
                      *(u32x2e*)(ACT + (size_t)(row0 + ai * HALF + m) * DFFc + g0 + 4 * n) = w; }
                }
            }
        }
    }
};

template <class Epi, class Sched, bool ALIGN_EPI = false, bool SP2 = false>
__device__ __forceinline__ void gemm_phase(PG8_LAS unsigned char* lds, const Gemm g, const Sched& S, const Epi& E, int tid_in) {
    int tid_raw = tid_in; asm volatile("" : "+v"(tid_raw));
    const int tid = tid_raw, wid = __builtin_amdgcn_readfirstlane(tid >> 6), lane = tid & 63, wr = wid >> 2, wc = (wid + (wid >> 2)) & 3, fr = lane & 15, fq = lane >> 4;
    const int K = g.K, nt = K / BK;
    unsigned voffA[2], voffB[2];
#pragma unroll
    for (int i = 0; i < 2; ++i) { int R, C; stage_rc(tid * 16 + i * 8192, R, C); const int Rb = Epi::PERM ? ((R & ~31) + perm32(R & 31)) : R;
        if (Epi::PERMA) R = (R & ~63) + 4 * (R & 15) + ((R >> 4) & 3);
        voffA[i] = (unsigned)(R * K + C) * 2u; voffB[i] = (unsigned)(Rb * K + C) * 2u; }
    const size_t kstep = (size_t)(BK * 2);
    const size_t hstep = (size_t)HALF * K * 2;
    const size_t tstep = 2 * hstep;
    const unsigned ldsw = (unsigned)wid * 1024u;
    const int aoff = lds_byte(wr * 64 + fr, fq * 8), boff = lds_byte(wc * 32 + fr, fq * 8);
#define PG8_SA(b, h) (((b) * 2 + (h)) * HTB)
#define PG8_SB(b, h) ((4 + (b) * 2 + (h)) * HTB)
#define PG8_STAGE(bufoff, gbase, voff) do { _Pragma("unroll") for (int _i = 0; _i < 2; ++_i) \
        __builtin_amdgcn_global_load_lds((const unsigned*)((const char*)(gbase) + (voff)[_i]), (PG8_LAS unsigned*)(lds + (bufoff) + ldsw + _i * 8192), 16, 0, 0); } while (0)
#define PG8_LDA(dst, b, h) do { _Pragma("unroll") for (int m = 0; m < 4; ++m) _Pragma("unroll") for (int k = 0; k < 2; ++k) dst[m][k] = *(const PG8_LAS bf16x8*)(lds + PG8_SA(b, h) + aoff + m * 2048 + k * 1024); } while (0)
#define PG8_LDB(dst, b, h) do { _Pragma("unroll") for (int n = 0; n < 2; ++n) _Pragma("unroll") for (int k = 0; k < 2; ++k) dst[n][k] = *(const PG8_LAS bf16x8*)(lds + PG8_SB(b, h) + boff + n * 2048 + k * 1024); } while (0)
#define PG8_MMA(ai, bj, At, Bt) do { __builtin_amdgcn_s_setprio(1); _Pragma("unroll") for (int m = 0; m < 4; ++m) _Pragma("unroll") for (int n = 0; n < 2; ++n) _Pragma("unroll") for (int k = 0; k < 2; ++k) \
        acc[ai][bj][m][n] = __builtin_amdgcn_mfma_f32_16x16x32_bf16(Bt[n][k], At[m][k], acc[ai][bj][m][n], 0, 0, 0); __builtin_amdgcn_s_setprio(0); } while (0)
#define PG8_WAIT_V(n) asm volatile("s_waitcnt vmcnt(" #n ")" ::: "memory")
#define PG8_WAIT_L(n) asm volatile("s_waitcnt lgkmcnt(" #n ")" ::: "memory")
#define PG8_BAR __builtin_amdgcn_s_barrier()
#define PG8_SCHED __builtin_amdgcn_sched_barrier(0)
    Unit cur, nxt; int ui = 0;
    if (!S.next(0, cur)) return;
    f32x4 acc[2][2][4][2];
#pragma unroll
    for (int a = 0; a < 2; ++a)
#pragma unroll
        for (int b = 0; b < 2; ++b)
#pragma unroll
            for (int m = 0; m < 4; ++m)
#pragma unroll
                for (int n = 0; n < 2; ++n) acc[a][b][m][n] = (f32x4){0.f, 0.f, 0.f, 0.f};
    bf16x8 At[4][2], B0[2][2], B1[2][2];
    const char* cA = (const char*)g.A + (size_t)cur.pm * tstep; const char* cB = (const char*)g.Bt + (size_t)cur.pn * tstep;
    S.a_ready(cur);
    if constexpr (SP2) {
        PG8_STAGE(PG8_SB(0, 0), cB, voffB); PG8_STAGE(PG8_SB(0, 1), cB + hstep, voffB); PG8_STAGE(PG8_SA(0, 0), cA, voffA); PG8_STAGE(PG8_SA(0, 1), cA + hstep, voffA);
        if (wr == 1) PG8_BAR;
        PG8_WAIT_V(2); PG8_BAR;
        PG8_STAGE(PG8_SB(1, 0), cB + kstep, voffB); PG8_STAGE(PG8_SA(1, 0), cA + kstep, voffA); PG8_STAGE(PG8_SB(1, 1), cB + hstep + kstep, voffB);
        PG8_WAIT_V(6); PG8_BAR;
    } else {
        PG8_STAGE(PG8_SB(0, 0), cB, voffB); PG8_STAGE(PG8_SA(0, 0), cA, voffA); PG8_STAGE(PG8_SB(0, 1), cB + hstep, voffB); PG8_STAGE(PG8_SA(0, 1), cA + hstep, voffA);
        if (wr == 1) PG8_BAR;
        PG8_WAIT_V(4); PG8_BAR;
        PG8_STAGE(PG8_SB(1, 0), cB + kstep, voffB); PG8_STAGE(PG8_SA(1, 0), cA + kstep, voffA); PG8_STAGE(PG8_SB(1, 1), cB + hstep + kstep, voffB);
        PG8_WAIT_V(6); PG8_BAR;
    }
    for (;;) {
        const bool has_next = S.next(ui + 1, nxt);
        const char* nA = has_next ? (const char*)g.A + (size_t)nxt.pm * tstep : cA; const char* nB = has_next ? (const char*)g.Bt + (size_t)nxt.pn * tstep : cB;
        for (int t = 0; t < nt; t += 2) {
            const bool last = (t == nt - 2);
            const char* a1 = cA + (size_t)(t + 1) * kstep;
            const char* a2 = last ? nA : cA + (size_t)(t + 2) * kstep; const char* b2 = last ? nB : cB + (size_t)(t + 2) * kstep;
            const char* a3 = a2 + kstep; const char* b3 = b2 + kstep;
            if (last && has_next) S.a_ready(nxt);
            if constexpr (SP2) {
            PG8_LDB(B0, 0, 0); PG8_LDB(B1, 0, 1); PG8_SCHED; PG8_LDA(At, 0, 0); PG8_STAGE(PG8_SA(1, 1), a1 + hstep, voffA);
            PG8_WAIT_V(8); PG8_WAIT_L(0); PG8_BAR; PG8_MMA(0, 0, At, B0); PG8_MMA(0, 1, At, B1); PG8_BAR; PG8_SCHED;
            PG8_LDA(At, 0, 1); PG8_STAGE(PG8_SB(0, 0), b2, voffB); PG8_STAGE(PG8_SB(0, 1), b2 + hstep, voffB); PG8_STAGE(PG8_SA(0, 0), a2, voffA);
            PG8_WAIT_V(8); PG8_WAIT_L(0); PG8_BAR; PG8_MMA(1, 0, At, B0); PG8_MMA(1, 1, At, B1); PG8_BAR; PG8_SCHED;
            PG8_LDB(B0, 1, 0); PG8_LDB(B1, 1, 1); PG8_SCHED; PG8_LDA(At, 1, 0); PG8_STAGE(PG8_SA(0, 1), a2 + hstep, voffA);
            PG8_WAIT_V(8); PG8_WAIT_L(0); PG8_BAR; PG8_MMA(0, 0, At, B0); PG8_MMA(0, 1, At, B1); PG8_BAR; PG8_SCHED;
            PG8_LDA(At, 1, 1); PG8_STAGE(PG8_SB(1, 0), b3, voffB); PG8_STAGE(PG8_SB(1, 1), b3 + hstep, voffB); PG8_STAGE(PG8_SA(1, 0), a3, voffA);
            PG8_WAIT_V(8); PG8_WAIT_L(0); PG8_BAR; PG8_MMA(1, 0, At, B0); PG8_MMA(1, 1, At, B1); PG8_BAR; PG8_SCHED;
            } else {
            PG8_LDB(B0, 0, 0); PG8_SCHED; PG8_LDA(At, 0, 0); PG8_STAGE(PG8_SA(1, 1), a1 + hstep, voffA);
            PG8_WAIT_L(8); PG8_BAR; PG8_WAIT_L(0); PG8_MMA(0, 0, At, B0); PG8_BAR; PG8_SCHED;
            PG8_LDB(B1, 0, 1); PG8_STAGE(PG8_SB(0, 0), b2, voffB);
            PG8_BAR; PG8_WAIT_L(0); PG8_MMA(0, 1, At, B1); PG8_BAR;
            PG8_LDA(At, 0, 1); PG8_STAGE(PG8_SA(0, 0), a2, voffA);
            PG8_BAR; PG8_WAIT_L(0); PG8_MMA(1, 0, At, B0); PG8_BAR; PG8_SCHED;
            PG8_STAGE(PG8_SB(0, 1), b2 + hstep, voffB);
            PG8_WAIT_V(6); PG8_BAR; PG8_MMA(1, 1, At, B1); PG8_BAR;
            PG8_LDB(B0, 1, 0); PG8_SCHED; PG8_LDA(At, 1, 0); PG8_STAGE(PG8_SA(0, 1), a2 + hstep, voffA);
            PG8_WAIT_L(8); PG8_BAR; PG8_WAIT_L(0); PG8_MMA(0, 0, At, B0); PG8_BAR; PG8_SCHED;
            PG8_LDB(B1, 1, 1); PG8_STAGE(PG8_SB(1, 0), b3, voffB);
            PG8_BAR; PG8_WAIT_L(0); PG8_MMA(0, 1, At, B1); PG8_BAR;
            PG8_LDA(At, 1, 1); PG8_STAGE(PG8_SA(1, 0), a3, voffA);
            PG8_BAR; PG8_WAIT_L(0); PG8_MMA(1, 0, At, B0); PG8_BAR; PG8_SCHED;
            PG8_STAGE(PG8_SB(1, 1), b3 + hstep, voffB);
            PG8_WAIT_V(6); PG8_BAR; PG8_MMA(1, 1, At, B1); PG8_BAR;
            }
        }
        if constexpr (ALIGN_EPI) { if (wr == 0) PG8_BAR; }
        if constexpr (!Epi::AFTER_DRAIN) { E(acc, cur, wr, wc, fr, fq); S.done(cur); }
        if (!has_next) break;
#pragma unroll
        for (int a = 0; a < 2; ++a)
#pragma unroll
            for (int b = 0; b < 2; ++b)
#pragma unroll
                for (int m = 0; m < 4; ++m)
#pragma unroll
                    for (int n = 0; n < 2; ++n) acc[a][b][m][n] = (f32x4){0.f, 0.f, 0.f, 0.f};
        cur = nxt; cA = nA; cB = nB; ++ui;
        if constexpr (ALIGN_EPI) { if (wr == 1) PG8_BAR; }
    }
    PG8_WAIT_V(0);
    if constexpr (!ALIGN_EPI) { if (wr == 0) PG8_BAR; }
    PG8_BAR;
    if constexpr (Epi::AFTER_DRAIN) { E.fused(acc, cur, wr, wc, fr, fq, lds, wid, lane); S.done(cur); }
#undef PG8_SA
#undef PG8_SB
#undef PG8_STAGE
#undef PG8_LDA
#undef PG8_LDB
#undef PG8_MMA
#undef PG8_WAIT_V
#undef PG8_WAIT_L
#undef PG8_BAR
#undef PG8_SCHED
}
}
#define XB_TMO      128
#define XB_XCNT(j)  (256  + 64 * (j))
#define XB_XSUB(j)  (1280 + 64 * (j))
#define XB_XGEN(j)  (2304 + 64 * (j))
#define XB_TOP      3328
#define XB_TOPGEN   3392
#define XCD_BAR_WORDS 3456
#define XB_SPIN_CAP (1u << 18)
#define LAS __attribute__((address_space(3)))

__device__ __forceinline__ unsigned xb_ld(unsigned* p)              { return __hip_atomic_load(p, __ATOMIC_RELAXED, __HIP_MEMORY_SCOPE_AGENT); }
__device__ __forceinline__ unsigned xb_add(unsigned* p, unsigned v) { return __hip_atomic_fetch_add(p, v, __ATOMIC_RELAXED, __HIP_MEMORY_SCOPE_AGENT); }
__device__ __forceinline__ unsigned xb_xcc_id() { return (unsigned)__builtin_amdgcn_s_getreg((3 << 11) | 20) & 0xFu; }
#define XB_SPIN(cond, bar) do { unsigned _sp = 0; while (cond) { __builtin_amdgcn_s_sleep(1); \
    if ((++_sp & 255u) == 0u) { if (xb_ld(&(bar)[XB_TMO])) break; if (_sp > XB_SPIN_CAP) { atomicAdd(&(bar)[XB_TMO], 1u); break; } } } } while (0)

struct XcdBarrier {
    unsigned* bar; unsigned x;
    volatile LAS unsigned* st;
    int lead;
};

__device__ __forceinline__ XcdBarrier xcd_barrier_post(unsigned* bar, volatile LAS unsigned* st) {
    XcdBarrier b; b.bar = bar; b.x = xb_xcc_id(); b.st = st; b.lead = (threadIdx.x == 0);
    if (threadIdx.x == 0) (void)xb_add(&bar[XB_XCNT(b.x)], 1u);
    return b;
}
__device__ __forceinline__ void xcd_barrier_complete(unsigned* bar, unsigned x, unsigned& nloc, unsigned& nx) {
    const unsigned G = gridDim.x * gridDim.y * gridDim.z;
    unsigned sum, cnt, mine, sp = 0u;
    for (;;) {
        sum = 0u; cnt = 0u; mine = 0u;
#pragma unroll
        for (unsigned j = 0; j < 16; ++j) { const unsigned c = xb_ld(&bar[XB_XCNT(j)]); sum += c; cnt += (c > 0u) ? 1u : 0u; mine = (j == x) ? c : mine; }
        if (sum == G) break;
        __builtin_amdgcn_s_sleep(1);
        if ((++sp & 255u) == 0u) { if (xb_ld(&bar[XB_TMO])) break; if (sp > XB_SPIN_CAP) { atomicAdd(&bar[XB_TMO], 1u); break; } }
    }
    nloc = mine > 0u ? mine : 1u; nx = cnt > 0u ? cnt : 1u;
}

__device__ __forceinline__ void xcd_barrier(const XcdBarrier& b) {
    asm volatile("s_waitcnt vmcnt(0)" ::: "memory");
    __syncthreads();
    if (b.lead) {
        unsigned* bar = b.bar;
        __builtin_amdgcn_s_waitcnt(0);
        unsigned nloc = b.st[0], nx = b.st[1];
        if (nloc == 0u) { xcd_barrier_complete(bar, b.x, nloc, nx); b.st[0] = nloc; b.st[1] = nx; }
        const unsigned old = xb_add(&bar[XB_XSUB(b.x)], 1u);
        const unsigned gen = old / nloc;
        if (old + 1u == (gen + 1u) * nloc) {
            __builtin_amdgcn_fence(__ATOMIC_RELEASE, "agent");
            asm volatile("s_waitcnt vmcnt(0)" ::: "memory");
            const unsigned og = xb_add(&bar[XB_TOP], 1u);
            const unsigned tg = og / nx;
            if (og + 1u == (tg + 1u) * nx) xb_add(&bar[XB_TOPGEN], 1u);
            else XB_SPIN(xb_ld(&bar[XB_TOPGEN]) == tg, bar);
            __builtin_amdgcn_fence(__ATOMIC_ACQUIRE, "agent");
            xb_add(&bar[XB_XGEN(b.x)], 1u);
            asm volatile("s_waitcnt vmcnt(0)" ::: "memory");
        } else {
            XB_SPIN(xb_ld(&bar[XB_XGEN(b.x)]) == gen, bar);
            __builtin_amdgcn_fence(__ATOMIC_ACQUIRE, "agent");
            asm volatile("s_waitcnt vmcnt(0)" ::: "memory");
        }
    }
    __syncthreads();
}

#define GAS __attribute__((address_space(1)))
using pg8::bf16_t; using pg8::bf16x8; using pg8::f32x4; using pg8::u32x4;
typedef short s16x4 __attribute__((ext_vector_type(4)));
typedef float f32x16 __attribute__((ext_vector_type(16)));
typedef unsigned u32x2 __attribute__((ext_vector_type(2)));

constexpr int D = 2048, BATCH = 4, SEQ = 4096, M = BATCH * SEQ, DEPTH = 4;
constexpr int AB_PAD = 5888, AB_COLS = 5656, C_COLS = 12288, DFF = 5632, DFF2 = 11264;
constexpr int NWAVES = 8, NTHREADS = 512;
constexpr float RMS_EPS = 1e-6f;

constexpr size_t MiB = (size_t)1 << 20;
constexpr size_t WS_CTL = 0, CTL_ZERO_BYTES = 1 * MiB;
constexpr size_t WS_KMEAN = 2 * MiB;
constexpr size_t WS_KC = 3 * MiB, WS_VC = 4 * MiB;
constexpr size_t WS_W1K = 5 * MiB, WS_W1V = 7 * MiB;
constexpr size_t WS_W2K = 9 * MiB, WS_W2V = 9 * MiB + 256 * 1024;
constexpr size_t WS_SSP = 10 * MiB;
constexpr size_t WS_MEMN = 16 * MiB;
constexpr size_t WS_MEMKV = 20 * MiB;
constexpr size_t WS_QX = 28 * MiB, WS_AX = 44 * MiB;
constexpr size_t WS_NQROT = 60 * MiB;
constexpr size_t WS_H = 96 * MiB;
constexpr size_t WS_HN = 224 * MiB;
constexpr size_t WS_R1 = 288 * MiB;
constexpr size_t WS_ACT = WS_R1 + 352 * MiB;
constexpr size_t WS_Y = WS_R1 + 384 * MiB;
constexpr size_t WS_WINAB = 816 * MiB;
constexpr size_t WS_WOUTAB = 862 * MiB;
constexpr size_t WS_WINC = 878 * MiB;
constexpr size_t WS_WOUTC = 974 * MiB;
constexpr size_t WS_WQX = 1006 * MiB;
constexpr size_t WS_WKVALL = 1014 * MiB;
constexpr size_t WS_WOX = 1030 * MiB;
constexpr size_t WS_WUP = 1038 * MiB;
constexpr size_t WS_WDOWN = 1214 * MiB;
constexpr size_t WS_ATT = 1302 * MiB;
constexpr size_t WS_END = 1366 * MiB;
constexpr int CW_BAR = 4096;
constexpr int CW_QUEUE = 16384;

constexpr int RING_BYTES = 147456;
constexpr int MISC_OFF = 147456;
constexpr int KMEAN_OFF = MISC_OFF + 1024;
constexpr int SELM_OFF = KMEAN_OFF + 8192;
constexpr int LDS_BYTES = 163840;

constexpr int PH_G0 = 0, PH_L0 = 1, PH_PER_LAYER = 10, PH_FINAL = 41, N_PHASES = 42;
constexpr int EPI_SCR_OFF = 131072;

#define MFMA32(a, b, c) __builtin_amdgcn_mfma_f32_32x32x16_bf16((a), (b), (c), 0, 0, 0)
typedef __bf16 bf16x2_t __attribute__((ext_vector_type(2)));
typedef float f32x2_t __attribute__((ext_vector_type(2)));
__device__ __forceinline__ unsigned cvtpk(float lo, float hi) { const f32x2_t f = {lo, hi}; const bf16x2_t v = __builtin_convertvector(f, bf16x2_t); return __builtin_bit_cast(unsigned, v); }
__device__ __forceinline__ float bflo(unsigned w) { return __uint_as_float(w << 16); }
__device__ __forceinline__ float bfhi(unsigned w) { return __uint_as_float(w & 0xffff0000u); }
__device__ __forceinline__ float bf2f(bf16_t v) { return __uint_as_float(((unsigned)v) << 16); }
__device__ __forceinline__ bf16_t f2bf(float f) { return (bf16_t)(cvtpk(f, f) & 0xffffu); }
__device__ __forceinline__ int crow(int r, int hi) { return (r & 3) + 8 * (r >> 2) + 4 * hi; }
__device__ __forceinline__ unsigned offb(unsigned row, unsigned ch) { return 256u * row + 16u * (ch ^ (((row & 3u) << 2) | ((row >> 2) & 3u))); }
__device__ __forceinline__ unsigned offv(unsigned row, unsigned ch) { return 128u * row + 16u * (ch ^ (((row >> 1) & 1u) << 2)); }
__device__ __forceinline__ float xhalf_max(float v) { auto rr = __builtin_amdgcn_permlane32_swap(__float_as_uint(v), __float_as_uint(v), false, false); return fmaxf(__uint_as_float(rr[0]), __uint_as_float(rr[1])); }
__device__ __forceinline__ float xhalf_sum(float v) { auto rr = __builtin_amdgcn_permlane32_swap(__float_as_uint(v), __float_as_uint(v), false, false); return __uint_as_float(rr[0]) + __uint_as_float(rr[1]); }
__device__ __forceinline__ float xhalf_get(float v, int hi) { auto rr = __builtin_amdgcn_permlane32_swap(__float_as_uint(v), __float_as_uint(v), false, false); return __uint_as_float(hi ? rr[0] : rr[1]); }
template <int MASK> __device__ __forceinline__ float shx(float v) { static_assert(MASK < 32, "shx: inside 32-lane groups"); return __int_as_float(__builtin_amdgcn_ds_swizzle(__float_as_int(v), (MASK << 10) | 0x1F)); }
template <int MASK> __device__ __forceinline__ unsigned shxu(unsigned v) { return (unsigned)__builtin_amdgcn_ds_swizzle((int)v, (MASK << 10) | 0x1F); }
__device__ __forceinline__ float wave_sum(float v) {
    v += shx<1>(v); v += shx<2>(v); v += shx<4>(v); v += shx<8>(v); v += shx<16>(v);
    return xhalf_sum(v);
}
__device__ __forceinline__ float fast_exp2(float x) { return __builtin_amdgcn_exp2f(x); }
__device__ __forceinline__ float silu_f(float x) { return x * __builtin_amdgcn_rcpf(1.0f + fast_exp2(-1.4426950408889634f * x)); }
__device__ __forceinline__ float sigmoid_f(float x) { return __builtin_amdgcn_rcpf(1.0f + fast_exp2(-1.4426950408889634f * x)); }
__device__ __forceinline__ void sincos_rad(float ang, float& sn, float& cs) {
    float rev = ang * 0.15915494309189535f; rev = rev - floorf(rev);
    sn = __builtin_amdgcn_sinf(rev); cs = __builtin_amdgcn_cosf(rev);
}
template <int OFF> __device__ __forceinline__ s16x4 tr_read(unsigned addr) { return __builtin_amdgcn_ds_read_tr16_b64_v4i16((LAS s16x4*)(uintptr_t)(addr + (unsigned)OFF)); }
__device__ __forceinline__ s16x4 tr_read0(unsigned addr) { return __builtin_amdgcn_ds_read_tr16_b64_v4i16((LAS s16x4*)(uintptr_t)addr); }
#define LGKM_WAIT0() do { } while (0)
#define PK8(L, H) (bf16x8){L[0], L[1], L[2], L[3], H[0], H[1], H[2], H[3]}
__device__ __forceinline__ bf16x8 pack8(float a0, float a1, float a2, float a3, float a4, float a5, float a6, float a7) {
    u32x4 w; w.x = cvtpk(a0, a1); w.y = cvtpk(a2, a3); w.z = cvtpk(a4, a5); w.w = cvtpk(a6, a7); return __builtin_bit_cast(bf16x8, w);
}
__device__ __forceinline__ void unpack8(u32x4 w, float (&x)[8]) {
    x[0] = bflo(w.x); x[1] = bfhi(w.x); x[2] = bflo(w.y); x[3] = bfhi(w.y); x[4] = bflo(w.z); x[5] = bfhi(w.z); x[6] = bflo(w.w); x[7] = bfhi(w.w);
}
__device__ __forceinline__ u32x4 packu8(const float (&x)[8]) { u32x4 w; w.x = cvtpk(x[0], x[1]); w.y = cvtpk(x[2], x[3]); w.z = cvtpk(x[4], x[5]); w.w = cvtpk(x[6], x[7]); return w; }

__device__ __forceinline__ void transpose_item(const float* W, const float* gain  , int K, int N, bf16_t* WT, LAS float* scr, int item, int nblk, int lane, bool ffn_perm = false, bool frag = false) {
    const int kb = item / nblk, nb = item - kb * nblk, k0 = 64 * kb, n0 = 64 * nb;
    const int cl = 4 * (lane & 15), nn = n0 + cl; const bool ok = nn < N;
    const float* src = W + (size_t)(k0 + (lane >> 4)) * N + nn;
    f32x4 vv[16];
#pragma unroll
    for (int i = 0; i < 16; ++i) vv[i] = ok ? *(const f32x4*)(src + (size_t)(4 * i) * N) : (f32x4){0.f, 0.f, 0.f, 0.f};
#pragma unroll
    for (int i = 0; i < 16; ++i) { f32x4 v = vv[i];
        if (gain) v = v * gain[k0 + 4 * i + (lane >> 4)];
        LAS float* d = scr + (4 * i + (lane >> 4)) * 65 + cl; d[0] = v.x; d[1] = v.y; d[2] = v.z; d[3] = v.w; }
    asm volatile("s_waitcnt lgkmcnt(0)" ::: "memory");
    const int c = lane & 7;
#pragma unroll
    for (int j = 0; j < 8; ++j) { const int n = (lane >> 3) + 8 * j; const LAS float* s = scr + (8 * c) * 65 + n;
        u32x4 o; o.x = cvtpk(s[0 * 65], s[1 * 65]); o.y = cvtpk(s[2 * 65], s[3 * 65]); o.z = cvtpk(s[4 * 65], s[5 * 65]); o.w = cvtpk(s[6 * 65], s[7 * 65]);
        const int nsrc = n0 + n; const int nd = !ffn_perm ? nsrc : (nsrc < 5632 ? 256 * (nsrc >> 7) + (nsrc & 127) : 256 * ((nsrc - 5632) >> 7) + 128 + ((nsrc - 5632) & 127));
        if (frag) { const int kk = k0 + 8 * c; *(u32x4*)(WT + ((size_t)((((nd >> 5) * 32 + (kk >> 7)) * 8 + ((kk & 127) >> 4)) * 64 + ((kk >> 3) & 1) * 32 + (nd & 31))) * 8) = o; }
        else *(u32x4*)(WT + (size_t)nd * K + k0 + 8 * c) = o; }
    asm volatile("s_waitcnt lgkmcnt(0)" ::: "memory");
}
__device__ __forceinline__ void transpose_matrix(const float* W, const float* gain, int K, int N, int Npad, bf16_t* WT, LAS float* scr, int gw, int ngw, int lane, int& base, bool ffn_perm = false, bool frag = false) {
    const int nblk = Npad / 64, nitems = (K / 64) * nblk;
    int start = (gw - base) % ngw; if (start < 0) start += ngw;
    for (int it = start; it < nitems; it += ngw) transpose_item(W, gain, K, N, WT, scr, it, nblk, lane, ffn_perm, frag);
    base = (base + nitems) % ngw;
}
__device__ __forceinline__ void rms_row_bf16(const float* xrow, const float* gain, bf16_t* orow, int lane) {
    const f32x4* xr = (const f32x4*)xrow + lane; const f32x4* gr = (const f32x4*)gain + lane;
    f32x4 v[8]; float s = 0.f;
#pragma unroll
    for (int j = 0; j < 8; ++j) { v[j] = xr[64 * j]; s += (v[j].x * v[j].x + v[j].y * v[j].y) + (v[j].z * v[j].z + v[j].w * v[j].w); }
    const float rstd = 1.0f / sqrtf(wave_sum(s) * (1.0f / 2048.0f) + RMS_EPS);
    u32x2* o8 = (u32x2*)orow + lane;
#pragma unroll
    for (int j = 0; j < 8; ++j) { const f32x4 g = gr[64 * j]; u32x2 w; w.x = cvtpk(v[j].x * rstd * g.x, v[j].y * rstd * g.y); w.y = cvtpk(v[j].z * rstd * g.z, v[j].w * rstd * g.w); o8[64 * j] = w; }
}
__device__ __forceinline__ float row_to_bf16_ss(const float* xrow, bf16_t* orow, int lane) {
    const f32x4* xr = (const f32x4*)xrow + lane; u32x2* o8 = (u32x2*)orow + lane; float s = 0.f;
#pragma unroll
    for (int j = 0; j < 8; ++j) { const f32x4 v = xr[64 * j]; s += (v.x * v.x + v.y * v.y) + (v.z * v.z + v.w * v.w); u32x2 w; w.x = cvtpk(v.x, v.y); w.y = cvtpk(v.z, v.w); o8[64 * j] = w; }
    return wave_sum(s);
}
__device__ __forceinline__ void rms_row_bf16in_f32(const bf16_t* xrow, const float* gain, float* orow, int lane) {
    const u32x2* xr = (const u32x2*)xrow + lane; float v[8][4]; float s = 0.f;
#pragma unroll
    for (int k = 0; k < 8; ++k) { const u32x2 w = xr[64 * k]; v[k][0] = bflo(w.x); v[k][1] = bfhi(w.x); v[k][2] = bflo(w.y); v[k][3] = bfhi(w.y);
        s += (v[k][0] * v[k][0] + v[k][1] * v[k][1]) + (v[k][2] * v[k][2] + v[k][3] * v[k][3]); }
    const float rstd = 1.0f / sqrtf(wave_sum(s) * (1.0f / 2048.0f) + RMS_EPS);
#pragma unroll
    for (int k = 0; k < 8; ++k) { const int c0 = 4 * lane + 256 * k; const f32x4 g = *(const f32x4*)(gain + c0);
        *(f32x4*)(orow + c0) = (f32x4){v[k][0] * rstd * g.x, v[k][1] * rstd * g.y, v[k][2] * rstd * g.z, v[k][3] * rstd * g.w}; }
}

constexpr float SM_SCALE = 0.08838834764831845f;
constexpr float SM_C = SM_SCALE * 1.4426950408889634f;
constexpr float NEGM = -3.0e38f, M_INIT = -1.0e30f;
constexpr float SM_THR = 8.0f / SM_SCALE;

struct KVStage { u32x4 k0, k1, v0, v1; };
__device__ __forceinline__ void kv_load(KVStage& s, const bf16_t* kp, const bf16_t* vp, size_t ld, int tid) {
    const int r0 = tid >> 4, c = (tid & 15) * 8;
    s.k0 = *(const u32x4*)(kp + (size_t)r0 * ld + c); s.k1 = *(const u32x4*)(kp + (size_t)(r0 + 32) * ld + c);
    s.v0 = *(const u32x4*)(vp + (size_t)r0 * ld + c); s.v1 = *(const u32x4*)(vp + (size_t)(r0 + 32) * ld + c);
}
__device__ __forceinline__ void kv_write(const KVStage& s, LAS unsigned char* kb, LAS unsigned char* vb, int tid) {
    const unsigned r0 = tid >> 4, ch = tid & 15;
    *(LAS u32x4*)(kb + offb(r0, ch)) = s.k0; *(LAS u32x4*)(kb + offb(r0 + 32, ch)) = s.k1;
    *(LAS u32x4*)(vb + offb(r0, ch)) = s.v0; *(LAS u32x4*)(vb + offb(r0 + 32, ch)) = s.v1;
}
constexpr int RK0 = 0, RV0 = 49152, KVR = 16384;
constexpr int R4K0 = 0, R4V0 = 65536;
__device__ __forceinline__ unsigned kv_dma_off(int w, int lane, unsigned ldb  ) {
    const unsigned row = 4u * (unsigned)w + ((unsigned)lane >> 4), ch = ((unsigned)lane & 15u) ^ (((row & 3u) << 2) | ((row >> 2) & 3u));
    return row * ldb + 16u * ch;
}
__device__ __forceinline__ void kv_dma_to(const bf16_t* kp, const bf16_t* vp, unsigned off, unsigned ld32b, LAS unsigned char* kb, LAS unsigned char* vb);
__device__ __forceinline__ void kv_dma(const bf16_t* kp, const bf16_t* vp, unsigned off, unsigned ld32b  , LAS unsigned char* lds, int stage, int w) {
    kv_dma_to(kp, vp, off, ld32b, lds + RK0 + stage * KVR + 1024 * w, lds + RV0 + stage * KVR + 1024 * w);
}
__device__ __forceinline__ void kv_dma_to(const bf16_t* kp, const bf16_t* vp, unsigned off, unsigned ld32b, LAS unsigned char* kb, LAS unsigned char* vb) {
    __builtin_amdgcn_global_load_lds((const unsigned*)((const char*)kp + off), (LAS unsigned*)kb, 16, 0, 0);
    __builtin_amdgcn_global_load_lds((const unsigned*)((const char*)kp + off + ld32b), (LAS unsigned*)(kb + 8192), 16, 0, 0);
    __builtin_amdgcn_global_load_lds((const unsigned*)((const char*)vp + off), (LAS unsigned*)vb, 16, 0, 0);
    __builtin_amdgcn_global_load_lds((const unsigned*)((const char*)vp + off + ld32b), (LAS unsigned*)(vb + 8192), 16, 0, 0);
}
#define RING_WAIT(has_next) do { if (has_next) asm volatile("s_waitcnt vmcnt(4)" ::: "memory"); else asm volatile("s_waitcnt vmcnt(0)" ::: "memory"); \
        __builtin_amdgcn_s_barrier(); asm volatile("" ::: "memory"); } while (0)
__device__ __forceinline__ void q_load(bf16x8 (&qr)[8], const bf16_t* qrow, int hi) {
#pragma unroll
    for (int s = 0; s < 8; ++s) qr[s] = *(const bf16x8*)(qrow + 16 * s + 8 * hi);
}
template <int HALF> __device__ __forceinline__ void qk_half(f32x16& p, LAS const unsigned char* kb, const bf16x8 (&qr)[8], int r32, int hi) {
    const f32x16 z = {0.f, 0.f, 0.f, 0.f, 0.f, 0.f, 0.f, 0.f, 0.f, 0.f, 0.f, 0.f, 0.f, 0.f, 0.f, 0.f};
    bf16x8 a[8];
#pragma unroll
    for (int s = 0; s < 8; ++s) a[s] = *(LAS const bf16x8*)(kb + offb(32 * HALF + r32, 2 * s + hi));
    __builtin_amdgcn_s_setprio(1);
    f32x16 pa = MFMA32(a[0], qr[0], z), pb = MFMA32(a[1], qr[1], z);
#pragma unroll
    for (int s = 2; s < 8; s += 2) { pa = MFMA32(a[s], qr[s], pa); pb = MFMA32(a[s + 1], qr[s + 1], pb); }
    __builtin_amdgcn_s_setprio(0);
#pragma unroll
    for (int i = 0; i < 16; ++i) p[i] = pa[i] + pb[i];
}
struct VAddr { unsigned pre[4][2]; };
__device__ __forceinline__ void vaddr_init(VAddr& va, int lane) {
    const unsigned hi = lane >> 5, blk = (lane >> 4) & 1, q = (lane & 15) >> 2, p = lane & 3;
#pragma unroll
    for (int t = 0; t < 2; ++t) {
        const unsigned lowx = (2 * blk + (p >> 1)) ^ ((2 * t + hi) & 3);
        const unsigned base = 2048u * t + 256u * (4 * hi + q) + 16u * lowx + 8u * (p & 1);
#pragma unroll
        for (int c = 0; c < 4; ++c) va.pre[c][t] = base + 64u * ((unsigned)c ^ q);
    }
}
__device__ __forceinline__ void softmax_update(f32x16& p, float& m, float& l, f32x16 (&o)[4], bool en = true) {
    float pmax = fmaxf(p[0], p[1]);
#pragma unroll
    for (int i = 2; i < 16; i += 2) pmax = fmaxf(fmaxf(pmax, p[i]), p[i + 1]);
    pmax = xhalf_max(pmax);
    pmax = en ? pmax : NEGM;
    if (!__all(pmax - m <= SM_THR)) {
        const float mn = fmaxf(m, pmax); const float alpha = fast_exp2((m - mn) * SM_C); m = mn; l *= alpha;
#pragma unroll
        for (int c = 0; c < 4; ++c)
#pragma unroll
            for (int i = 0; i < 16; ++i) o[c][i] *= alpha;
    }
    const float cs = en ? SM_C : 0.f, mc = en ? -m * SM_C : -1.0e30f;
    const f32x2_t cs2 = {cs, cs}, mc2 = {mc, mc}; f32x2_t ps2 = {0.f, 0.f};
#pragma unroll
    for (int i = 0; i < 16; i += 2) { f32x2_t x = {p[i], p[i + 1]}; x = __builtin_elementwise_fma(x, cs2, mc2); x.x = fast_exp2(x.x); x.y = fast_exp2(x.y); p[i] = x.x; p[i + 1] = x.y; ps2 += x; }
    l += xhalf_sum(ps2.x + ps2.y);
}
template <int HALF> __device__ __forceinline__ void pv_half(f32x16 (&o)[4], const f32x16& p, unsigned vb, const VAddr& va) {
    bf16x8 pa[2];
    pa[0] = pack8(p[0], p[1], p[2], p[3], p[4], p[5], p[6], p[7]);
    pa[1] = pack8(p[8], p[9], p[10], p[11], p[12], p[13], p[14], p[15]);
    s16x4 l0[4], h0[4], l1[4], h1[4];
#pragma unroll
    for (int c = 0; c < 4; ++c) { const unsigned a0 = vb + va.pre[c][0], a1 = vb + va.pre[c][1];
        l0[c] = tr_read<8192 * HALF>(a0); h0[c] = tr_read<8192 * HALF>(a1); l1[c] = tr_read<8192 * HALF + 4096>(a0); h1[c] = tr_read<8192 * HALF + 4096>(a1); }
    LGKM_WAIT0();
    __builtin_amdgcn_s_setprio(1);
#pragma unroll
    for (int c = 0; c < 4; ++c) o[c] = MFMA32(PK8(l0[c], h0[c]), pa[0], o[c]);
#pragma unroll
    for (int c = 0; c < 4; ++c) o[c] = MFMA32(PK8(l1[c], h1[c]), pa[1], o[c]);
    __builtin_amdgcn_s_setprio(0);
}
struct SmState { float cs, mc, alpha; };
__device__ __forceinline__ bool sm_begin(const f32x16& p, bool en, float& m, SmState& s) {
    float pmax = fmaxf(p[0], p[1]);
#pragma unroll
    for (int i = 2; i < 16; i += 2) pmax = fmaxf(fmaxf(pmax, p[i]), p[i + 1]);
    pmax = xhalf_max(pmax);
    pmax = en ? pmax : NEGM;
    const bool resc = !__all(pmax - m <= SM_THR);
    const float mn = resc ? fmaxf(m, pmax) : m;
    s.alpha = fast_exp2((m - mn) * SM_C); m = mn;
    s.cs = en ? SM_C : 0.f; s.mc = en ? -mn * SM_C : -1.0e30f;
    return resc;
}
__device__ __forceinline__ void sm_finish(f32x16& p, const SmState& s, float& l, bf16x8 (&pa)[2]) {
    const f32x2_t cs2 = {s.cs, s.cs}, mc2 = {s.mc, s.mc}; f32x2_t ps2 = {0.f, 0.f};
#pragma unroll
    for (int i = 0; i < 16; i += 2) { f32x2_t x = {p[i], p[i + 1]}; x = __builtin_elementwise_fma(x, cs2, mc2); x.x = fast_exp2(x.x); x.y = fast_exp2(x.y); p[i] = x.x; p[i + 1] = x.y; ps2 += x; }
    l = l * s.alpha + xhalf_sum(ps2.x + ps2.y);
    pa[0] = pack8(p[0], p[1], p[2], p[3], p[4], p[5], p[6], p[7]);
    pa[1] = pack8(p[8], p[9], p[10], p[11], p[12], p[13], p[14], p[15]);
}
__device__ __forceinline__ s16x4 tr_rd(unsigned addr) { return __builtin_amdgcn_ds_read_tr16_b64_v4i16((LAS s16x4*)(uintptr_t)addr); }
template <int HALF> __device__ __forceinline__ void pv_half_pa(f32x16 (&o)[4], const bf16x8 (&pa)[2], unsigned vb, const VAddr& va) {
    s16x4 l0[4], h0[4], l1[4], h1[4];
#pragma unroll
    for (int c = 0; c < 4; ++c) { const unsigned a0 = vb + va.pre[c][0] + 8192 * HALF, a1 = vb + va.pre[c][1] + 8192 * HALF;
        l0[c] = tr_rd(a0); h0[c] = tr_rd(a1); l1[c] = tr_rd(a0 + 4096); h1[c] = tr_rd(a1 + 4096); }
#pragma unroll
    for (int c = 0; c < 4; ++c) o[c] = MFMA32(PK8(l0[c], h0[c]), pa[0], o[c]);
#pragma unroll
    for (int c = 0; c < 4; ++c) o[c] = MFMA32(PK8(l1[c], h1[c]), pa[1], o[c]);
}
__device__ __forceinline__ void o_scale(f32x16 (&o)[4], float alpha) {
#pragma unroll
    for (int c = 0; c < 4; ++c)
#pragma unroll
        for (int i = 0; i < 16; ++i) o[c][i] *= alpha;
}
template <int HALF> __device__ __forceinline__ void qk_half_lean(f32x16& p, LAS const unsigned char* kb, const bf16x8 (&qr)[8], int r32, int hi) {
#pragma unroll
    for (int i = 0; i < 16; ++i) p[i] = 0.f;
#pragma unroll
    for (int s = 0; s < 8; ++s) {
        const bf16x8 a0 = *(LAS const bf16x8*)(kb + offb(32 * HALF + r32, 2 * s + hi));
        p = MFMA32(a0, qr[s], p);
    }
}
template <int HALF> __device__ __forceinline__ void pv_one_lean(f32x16& od, unsigned a0, unsigned a1, const bf16x8 (&pa)[2]) {
    const s16x4 l0 = tr_read<8192 * HALF>(a0), h0 = tr_read<8192 * HALF>(a1), l1 = tr_read<8192 * HALF + 4096>(a0), h1 = tr_read<8192 * HALF + 4096>(a1);
    LGKM_WAIT0();
    od = MFMA32(PK8(l0, h0), pa[0], od); od = MFMA32(PK8(l1, h1), pa[1], od);
}
template <int HALF> __device__ __forceinline__ void pv_half_lean(f32x16 (&o)[4], const f32x16& p, unsigned vb, const VAddr& va) {
    bf16x8 pa[2];
    pa[0] = pack8(p[0], p[1], p[2], p[3], p[4], p[5], p[6], p[7]);
    pa[1] = pack8(p[8], p[9], p[10], p[11], p[12], p[13], p[14], p[15]);
    pv_one_lean<HALF>(o[0], vb + va.pre[0][0], vb + va.pre[0][1], pa);
    pv_one_lean<HALF>(o[1], vb + va.pre[1][0], vb + va.pre[1][1], pa);
    pv_one_lean<HALF>(o[2], vb + va.pre[2][0], vb + va.pre[2][1], pa);
    pv_one_lean<HALF>(o[3], vb + va.pre[3][0], vb + va.pre[3][1], pa);
}
template <bool ACC> __device__ __forceinline__ void o_store(const f32x16 (&o)[4], float sc, bf16_t* orow, int hi) {
    u32x2 old[4][4];
    if (ACC) {
#pragma unroll
        for (int c = 0; c < 4; ++c)
#pragma unroll
            for (int g = 0; g < 4; ++g) old[c][g] = *(const u32x2*)(orow + 32 * c + 8 * g + 4 * hi);
        asm volatile("" ::: "memory");
    }
#pragma unroll
    for (int c = 0; c < 4; ++c)
#pragma unroll
        for (int k = 0; k < 2; ++k) {
            u32x2 w[2];
#pragma unroll
            for (int e = 0; e < 2; ++e) { const int g = 2 * k + e;
                float a0 = o[c][4 * g] * sc, a1 = o[c][4 * g + 1] * sc, a2 = o[c][4 * g + 2] * sc, a3 = o[c][4 * g + 3] * sc;
                if (ACC) { a0 += bflo(old[c][g].x); a1 += bfhi(old[c][g].x); a2 += bflo(old[c][g].y); a3 += bfhi(old[c][g].y); }
                w[e].x = cvtpk(a0, a1); w[e].y = cvtpk(a2, a3); }
            const auto rx = __builtin_amdgcn_permlane32_swap(w[0].x, w[1].x, false, false);
            const auto ry = __builtin_amdgcn_permlane32_swap(w[0].y, w[1].y, false, false);
            u32x4 q; q.x = rx[0]; q.y = ry[0]; q.z = rx[1]; q.w = ry[1];
            *(u32x4*)(orow + 32 * c + 16 * k + 8 * hi) = q;
        }
}
#define O_ZERO(o) do { _Pragma("unroll") for (int _c = 0; _c < 4; ++_c) _Pragma("unroll") for (int _i = 0; _i < 16; ++_i) (o)[_c][_i] = 0.f; } while (0)

constexpr float LOG2_THETA_AB = 18.931568569324174f;
constexpr float LOG2_THETA_RET = 13.287712379549449f;

__device__ __forceinline__ void moba_prep_item(const bf16_t* PROJ, float* KMEAN, int b, int h, int blk, LAS unsigned char* lds, int tid) {
    const int c = tid & 15, tg = tid >> 4; const int tok0 = b * SEQ + 256 * blk + tg * 8;
    LAS float* PART = (LAS float*)lds;
    float csum[8];
#pragma unroll
    for (int j = 0; j < 8; ++j) csum[j] = 0.f;
#pragma unroll
    for (int i = 0; i < 8; ++i) { float x[8]; unpack8(*(const u32x4*)(PROJ + (size_t)(tok0 + i) * AB_PAD + 1024 + h * 128 + 8 * c), x);
#pragma unroll
        for (int j = 0; j < 8; ++j) csum[j] += x[j]; }
#pragma unroll
    for (int j = 0; j < 8; ++j) PART[tg * 128 + 8 * c + j] = csum[j];
    __syncthreads();
    if (tid < 128) { float s = 0.f; for (int g = 0; g < 32; ++g) s += PART[g * 128 + tid]; KMEAN[(((size_t)b * 8 + h) * 16 + blk) * 128 + tid] = s * (1.0f / 256.0f); }
    __syncthreads();
}
__device__ __forceinline__ void compress_item(const bf16_t* PROJ, const float* pe, const bf16_t* w1t  , const bf16_t* w2t  , bf16_t* OUT  ,
                                              int b, int g, int rb, int col0, LAS unsigned char* lds, int tid) {
    const int w = __builtin_amdgcn_readfirstlane(tid >> 6), lane = tid & 63, r32 = lane & 31, hi = lane >> 5;
    int n = 32 * rb + r32; if (n > 254) n = 254;
    const bf16_t* arow = PROJ + (size_t)(b * SEQ + 16 * n) * AB_PAD + col0 + g * 128 + 8 * hi;
    f32x16 acc[4];
#pragma unroll
    for (int c = 0; c < 4; ++c)
#pragma unroll
        for (int i = 0; i < 16; ++i) acc[c][i] = 0.f;
    for (int t = 4 * w; t < 4 * w + 4; ++t) {
#pragma unroll
        for (int s = 0; s < 8; ++s) {
            float x[8]; unpack8(*(const u32x4*)(arow + (size_t)t * AB_PAD + 16 * s), x);
            const f32x4 e0 = *(const f32x4*)(pe + t * 128 + 16 * s + 8 * hi), e1 = *(const f32x4*)(pe + t * 128 + 16 * s + 8 * hi + 4);
            const bf16x8 a = pack8(x[0] + e0.x, x[1] + e0.y, x[2] + e0.z, x[3] + e0.w, x[4] + e1.x, x[5] + e1.y, x[6] + e1.z, x[7] + e1.w);
#pragma unroll
            for (int c = 0; c < 4; ++c) { const bf16x8 bb = *(const bf16x8*)(w1t + ((size_t)(((c * 32 + t) * 8 + s) * 64 + lane)) * 8); acc[c] = MFMA32(a, bb, acc[c]); }
        }
    }
    LAS float* RED = (LAS float*)lds;
    LAS bf16_t* HS = (LAS bf16_t*)(lds + 135168);
    __syncthreads();
#pragma unroll
    for (int c = 0; c < 4; ++c)
#pragma unroll
        for (int i = 0; i < 16; ++i) RED[(w * 32 + crow(i, hi)) * 129 + 32 * c + r32] = acc[c][i];
    __syncthreads();
    { const int row = tid >> 4, c0 = 8 * (tid & 15);
#pragma unroll
      for (int j = 0; j < 8; ++j) { float sacc = 0.f;
#pragma unroll
          for (int ww = 0; ww < 8; ++ww) sacc += RED[(ww * 32 + row) * 129 + c0 + j];
          HS[row * 136 + c0 + j] = f2bf(silu_f(sacc)); } }
    __syncthreads();
    if (w < 4) {
        const int cb = w;
        f32x16 a2;
#pragma unroll
        for (int i = 0; i < 16; ++i) a2[i] = 0.f;
#pragma unroll
        for (int s = 0; s < 8; ++s) {
            const bf16x8 a = *(LAS const bf16x8*)(HS + r32 * 136 + 16 * s + 8 * hi);
            const bf16x8 bb = *(const bf16x8*)(w2t + (size_t)(32 * cb + r32) * 128 + 16 * s + 8 * hi);
            a2 = MFMA32(a, bb, a2);
        }
#pragma unroll
        for (int i = 0; i < 16; ++i) { const int no = 32 * rb + crow(i, hi); OUT[(size_t)no * 128 + 32 * cb + r32] = (no < 255) ? f2bf(a2[i]) : (bf16_t)0; }
    }
    __syncthreads();
}

constexpr int KB0 = 0, VB0 = 32768, KVB = 16384;

template <int HALF> __device__ __forceinline__ void moba_half(f32x16 (&o)[4], float& m, float& l, const bf16x8 (&qr)[8], LAS const unsigned char* kb, unsigned vb, const VAddr& va,
                                                              bool own, bool selected, int tq, int qloc, int w, int r32, int hi) {
    if (own && 64 * tq + 32 * HALF > 32 * w + 31) return;
    f32x16 p; qk_half<HALF>(p, kb, qr, r32, hi);
    if (own) {
        const int lim = qloc - 64 * tq - 32 * HALF - 4 * hi;
#pragma unroll
        for (int i = 0; i < 16; ++i) p[i] = (((i & 3) + 8 * (i >> 2)) <= lim) ? p[i] : NEGM;
    }
    softmax_update(p, m, l, o, own || selected);
    pv_half<HALF>(o, p, vb, va);
}
__device__ __forceinline__ void moba_unit(const bf16_t* PROJ, const float* KMEAN, bf16_t* ATT, int b, int h, int qb, LAS unsigned char* lds, int tid) {
    const int w = __builtin_amdgcn_readfirstlane(tid >> 6), lane = tid & 63, r32 = lane & 31, hi = lane >> 5;
    const int tokb = b * SEQ;
    const int qloc = 32 * w + r32;
    const size_t qtok = (size_t)(tokb + 256 * qb + qloc);
    LAS float* KM = (LAS float*)(lds + KMEAN_OFF);
    LAS unsigned* UNI = (LAS unsigned*)(lds + MISC_OFF + 256);
    __syncthreads();
    { const float* src = KMEAN + ((size_t)b * 8 + h) * 2048; for (int i = tid; i < 2048; i += NTHREADS) KM[i] = src[i]; if (tid == 0) UNI[0] = 0u; }
    bf16x8 qr[8]; q_load(qr, PROJ + qtok * AB_PAD + h * 128, hi);
    __syncthreads();
    unsigned sel = 0u;
    {
        float v0 = -3.0e38f, v1 = -3.0e38f, v2 = -3.0e38f; int i0 = -1, i1 = -1, i2 = -1;
        for (int j = 0; j < qb; ++j) {
            float gsum = 0.f;
#pragma unroll
            for (int s = 0; s < 8; ++s) {
                float x[8]; unpack8(__builtin_bit_cast(u32x4, qr[s]), x);
                const f32x4 k0 = *(LAS const f32x4*)(KM + j * 128 + 16 * s + 8 * hi), k1 = *(LAS const f32x4*)(KM + j * 128 + 16 * s + 8 * hi + 4);
                gsum += (x[0] * k0.x + x[1] * k0.y) + (x[2] * k0.z + x[3] * k0.w) + (x[4] * k1.x + x[5] * k1.y) + (x[6] * k1.z + x[7] * k1.w);
            }
            const float gv = xhalf_sum(gsum);
            const bool a0 = gv > v0, a1 = gv > v1, a2 = gv > v2;
            v2 = a1 ? v1 : (a2 ? gv : v2); i2 = a1 ? i1 : (a2 ? j : i2);
            v1 = a0 ? v0 : (a1 ? gv : v1); i1 = a0 ? i0 : (a1 ? j : i1);
            v0 = a0 ? gv : v0;             i0 = a0 ? j : i0;
        }
        if (i0 >= 0) sel |= 1u << i0;
        if (i1 >= 0) sel |= 1u << i1;
        if (i2 >= 0) sel |= 1u << i2;
    }
    { unsigned u = sel;
      u |= shxu<1>(u); u |= shxu<2>(u); u |= shxu<4>(u); u |= shxu<8>(u); u |= shxu<16>(u);
      { auto rr = __builtin_amdgcn_permlane32_swap(u, u, false, false); u = rr[0] | rr[1]; }
      if (lane == 0) __hip_atomic_fetch_or(UNI, u, __ATOMIC_RELAXED, __HIP_MEMORY_SCOPE_WORKGROUP); }
    __syncthreads();
    const unsigned umask = (unsigned)__builtin_amdgcn_readfirstlane(UNI[0]) | (1u << qb);
    const int nT = 4 * (qb + 1);
    const bf16_t* Kh = PROJ + (size_t)tokb * AB_PAD + 1024 + h * 128; const bf16_t* Vh = PROJ + (size_t)tokb * AB_PAD + 2048 + h * 128;
    VAddr va; vaddr_init(va, lane);
    f32x16 o[4]; O_ZERO(o); float m = M_INIT, l = 0.f;
    const unsigned lbase = (unsigned)(uintptr_t)lds;
    const unsigned doff = kv_dma_off(w, lane, AB_PAD * 2);
    auto nxt_tile = [&](int g) { int n = g + 1; while (n < nT && !((umask >> (n >> 2)) & 1u)) n = ((n >> 2) + 1) << 2; return n < nT ? n : nT - 1; };
    int g0 = 0; while (!((umask >> (g0 >> 2)) & 1u)) g0 = ((g0 >> 2) + 1) << 2;
    int g1 = nxt_tile(g0), g2 = nxt_tile(g1), g3 = nxt_tile(g2);
#define MOBA_DMA(g, stage) kv_dma_to(Kh + (size_t)(g) * 64 * AB_PAD, Vh + (size_t)(g) * 64 * AB_PAD, doff, 32 * AB_PAD * 2, lds + R4K0 + (stage) * KVR + 1024 * w, lds + R4V0 + (stage) * KVR + 1024 * w)
    MOBA_DMA(g0, 0); MOBA_DMA(g1, 1); MOBA_DMA(g2, 2);
    asm volatile("s_waitcnt vmcnt(8)" ::: "memory"); __builtin_amdgcn_s_barrier(); asm volatile("" ::: "memory");
    f32x16 p0, p1; SmState s0, s1; bf16x8 pa[2];
    int stg = 0; bool last = (g0 == nT - 1);
    {
        const int blk = g0 >> 2; const bool own = (blk == qb);
        qk_half_lean<0>(p0, lds + R4K0, qr, r32, hi);
        if (own) { const int lim = qloc - 64 * (g0 & 3) - 4 * hi;
#pragma unroll
            for (int i = 0; i < 16; ++i) p0[i] = (((i & 3) + 8 * (i >> 2)) <= lim) ? p0[i] : NEGM; }
        if (sm_begin(p0, own || ((sel >> blk) & 1u), m, s0)) o_scale(o, s0.alpha);
    }
    for (;;) {
        int lane_ = lane; asm volatile("" : "+v"(lane_)); const int r32 = lane_ & 31, hi = lane_ >> 5;
        LAS const unsigned char* kb = lds + R4K0 + stg * KVR; const unsigned vb = lbase + R4V0 + stg * KVR;
        const int blk = g0 >> 2, tq = g0 & 3; const bool own = (blk == qb); const bool en = own || ((sel >> blk) & 1u);
        qk_half_lean<1>(p1, kb, qr, r32, hi);
        sm_finish(p0, s0, l, pa);
        pv_half_pa<0>(o, pa, vb, va);
        if (own) { const int lim = qloc - 64 * tq - 32 - 4 * hi;
#pragma unroll
            for (int i = 0; i < 16; ++i) p1[i] = (((i & 3) + 8 * (i >> 2)) <= lim) ? p1[i] : NEGM; }
        if (sm_begin(p1, en, m, s1)) o_scale(o, s1.alpha);
        if (last) break;
        asm volatile("s_waitcnt vmcnt(4)" ::: "memory"); __builtin_amdgcn_s_barrier(); asm volatile("" ::: "memory");
        MOBA_DMA(g3, (stg + 3) & 3);
        const int nstg = (stg + 1) & 3;
        {
            const int nblk = g1 >> 2; const bool nown = (nblk == qb);
            qk_half_lean<0>(p0, lds + R4K0 + nstg * KVR, qr, r32, hi);
            sm_finish(p1, s1, l, pa);
            pv_half_pa<1>(o, pa, vb, va);
            if (nown) { const int lim = qloc - 64 * (g1 & 3) - 4 * hi;
#pragma unroll
                for (int i = 0; i < 16; ++i) p0[i] = (((i & 3) + 8 * (i >> 2)) <= lim) ? p0[i] : NEGM; }
            if (sm_begin(p0, nown || ((sel >> nblk) & 1u), m, s0)) o_scale(o, s0.alpha);
        }
        g0 = g1; g1 = g2; g2 = g3; g3 = nxt_tile(g3); stg = nstg; last = (g0 == nT - 1);
    }
    { sm_finish(p1, s1, l, pa); pv_half_pa<1>(o, pa, lbase + R4V0 + stg * KVR, va); }
#undef MOBA_DMA
    asm volatile("s_waitcnt vmcnt(0)" ::: "memory");
    o_store<false>(o, __builtin_amdgcn_rcpf(l), ATT + qtok * D + h * 128, hi);
}

__device__ __forceinline__ void cross_unit(const bf16_t* QX, const bf16_t* MEMKV, bf16_t* AX, int layer, int b, int head, int qb, LAS unsigned char* lds, int tid) {
    const int w = __builtin_amdgcn_readfirstlane(tid >> 6), lane = tid & 63, r32 = lane & 31, hi = lane >> 5;
    const size_t qtok = (size_t)(b * SEQ + 256 * qb + 32 * w + r32);
    const bf16_t* Kh = MEMKV + (size_t)(b * 256) * 4096 + layer * 1024 + head * 128; const bf16_t* Vh = Kh + 512;
    bf16x8 qr[8]; q_load(qr, QX + qtok * 512 + head * 128, hi);
    VAddr va; vaddr_init(va, lane);
    f32x16 o[4]; O_ZERO(o); float m = M_INIT, l = 0.f;
    const unsigned lbase = (unsigned)(uintptr_t)lds;
    const unsigned doff = kv_dma_off(w, lane, 4096 * 2);
    __syncthreads();
    kv_dma(Kh, Vh, doff, 32 * 4096 * 2, lds, 0, w); kv_dma(Kh + (size_t)64 * 4096, Vh + (size_t)64 * 4096, doff, 32 * 4096 * 2, lds, 1, w);
#pragma unroll
    for (int t = 0; t < 4; ++t) {
        const int stg = t % 3;
        RING_WAIT(t + 1 < 4);
        if (t + 2 < 4) kv_dma(Kh + (size_t)(t + 2) * 64 * 4096, Vh + (size_t)(t + 2) * 64 * 4096, doff, 32 * 4096 * 2, lds, (t + 2) % 3, w);
        { f32x16 p; qk_half<0>(p, lds + RK0 + stg * KVR, qr, r32, hi); softmax_update(p, m, l, o); pv_half<0>(o, p, lbase + RV0 + stg * KVR, va); }
        { f32x16 p; qk_half<1>(p, lds + RK0 + stg * KVR, qr, r32, hi); softmax_update(p, m, l, o); pv_half<1>(o, p, lbase + RV0 + stg * KVR, va); }
    }
    o_store<false>(o, __builtin_amdgcn_rcpf(l), AX + qtok * 512 + head * 128, hi);
}

template <class NextF, class DmaF, class MaskF>
__device__ __forceinline__ void ring_attention(f32x16 (&o)[4], float& m, float& l, const bf16x8 (&qr)[8], const VAddr& va, LAS unsigned char* lds, unsigned lbase, int lane,
                                               int gfirst, int glast, NextF next, DmaF dma, MaskF mask) {
    int g0 = gfirst, g1 = next(g0), g2 = next(g1), g3 = next(g2);
    dma(g0, 0); dma(g1, 1); dma(g2, 2);
    asm volatile("s_waitcnt vmcnt(8)" ::: "memory"); __builtin_amdgcn_s_barrier(); asm volatile("" ::: "memory");
    f32x16 p0, p1; SmState s0, s1; bf16x8 pa[2];
    int stg = 0; bool last = (g0 == glast);
    { int lane_ = lane; asm volatile("" : "+v"(lane_)); const int r32 = lane_ & 31, hi = lane_ >> 5;
      qk_half_lean<0>(p0, lds + R4K0, qr, r32, hi);
      const bool en = mask(g0, 0, p0);
      if (sm_begin(p0, en, m, s0)) o_scale(o, s0.alpha); }
    for (;;) {
        int lane_ = lane; asm volatile("" : "+v"(lane_)); const int r32 = lane_ & 31, hi = lane_ >> 5;
        LAS const unsigned char* kb = lds + R4K0 + stg * KVR; const unsigned vb = lbase + R4V0 + stg * KVR;
        qk_half_lean<1>(p1, kb, qr, r32, hi);
        sm_finish(p0, s0, l, pa);
        pv_half_pa<0>(o, pa, vb, va);
        { const bool en = mask(g0, 1, p1); if (sm_begin(p1, en, m, s1)) o_scale(o, s1.alpha); }
        if (last) break;
        asm volatile("s_waitcnt vmcnt(4)" ::: "memory"); __builtin_amdgcn_s_barrier(); asm volatile("" ::: "memory");
        dma(g3, (stg + 3) & 3);
        const int nstg = (stg + 1) & 3;
        qk_half_lean<0>(p0, lds + R4K0 + nstg * KVR, qr, r32, hi);
        sm_finish(p1, s1, l, pa);
        pv_half_pa<1>(o, pa, vb, va);
        { const bool en = mask(g1, 0, p0); if (sm_begin(p0, en, m, s0)) o_scale(o, s0.alpha); }
        g0 = g1; g1 = g2; g2 = g3; g3 = next(g3); stg = nstg; last = (g0 == glast);
    }
    { sm_finish(p1, s1, l, pa); pv_half_pa<1>(o, pa, lbase + R4V0 + stg * KVR, va); }
    asm volatile("s_waitcnt vmcnt(0)" ::: "memory");
}

constexpr int IMPH_OFF = 65536;
template <int HALF> __device__ __forceinline__ void cmp_stats_half(float& m, float& l, const bf16x8 (&qr)[8], LAS const unsigned char* kb, int t, int nmax, int r32, int hi) {
    f32x16 p; qk_half_lean<HALF>(p, kb, qr, r32, hi);
    float pmax = NEGM;
#pragma unroll
    for (int i = 0; i < 16; ++i) { const int n = 64 * t + 32 * HALF + crow(i, hi); p[i] = (n <= nmax) ? p[i] : NEGM; pmax = fmaxf(pmax, p[i]); }
    pmax = xhalf_max(pmax);
    const float mn = fmaxf(m, pmax); float ps = 0.f; const float mc = -mn * SM_C;
#pragma unroll
    for (int i = 0; i < 16; ++i) ps += fast_exp2(fmaf(p[i], SM_C, mc));
    l = l * fast_exp2((m - mn) * SM_C) + xhalf_sum(ps); m = mn;
}
template <int HALF> __device__ __forceinline__ void cmp_acc_half(f32x16 (&o)[4], float& prevT, const bf16x8 (&qr)[8], LAS const unsigned char* kb, unsigned vb, const VAddr& va, LAS float* IMPH,
                                                                 int t, int nmax, float mc, float inv_l, int r, int tokl, int r32, int hi) {
    f32x16 p; qk_half_lean<HALF>(p, kb, qr, r32, hi);
#pragma unroll
    for (int i = 0; i < 16; ++i) { const int n = 64 * t + 32 * HALF + crow(i, hi); p[i] = (n <= nmax) ? fast_exp2(fmaf(p[i], SM_C, mc)) : 0.f; }
#pragma unroll
    for (int gi = 0; gi < 4; ++gi) {
        const float gs = (p[4 * gi] + p[4 * gi + 1]) + (p[4 * gi + 2] + p[4 * gi + 3]);
        const float T = xhalf_get(p[4 * gi + 3], hi);
        const float val = gs + (hi ? T : prevT); prevT = T;
        const int a = 16 * t + 8 * HALF + 2 * gi + hi;
        IMPH[(r * 64 + a) * 64 + tokl] = val * inv_l;
    }
    pv_half_lean<HALF>(o, p, vb, va);
}
template <int HALF> __device__ __forceinline__ void sel_half(f32x16 (&o)[4], float& m, float& l, const bf16x8 (&qr)[8], LAS const unsigned char* kb, unsigned vb, const VAddr& va,
                                                             bool sel, bool own, int tokl, int r32, int hi) {
    f32x16 p; qk_half_lean<HALF>(p, kb, qr, r32, hi);
    if (own) {
        const int lim = tokl - 32 * HALF - 4 * hi;
#pragma unroll
        for (int i = 0; i < 16; ++i) p[i] = (((i & 3) + 8 * (i >> 2)) <= lim) ? p[i] : NEGM;
    }
    softmax_update(p, m, l, o, sel);
    pv_half_lean<HALF>(o, p, vb, va);
}
template <int HALF> __device__ __forceinline__ void win_half(f32x16 (&o)[4], float& m, float& l, const bf16x8 (&qr)[8], LAS const unsigned char* kb, unsigned vb, const VAddr& va,
                                                             bool edge, int pos, int j, int r32, int hi) {
    f32x16 p; qk_half_lean<HALF>(p, kb, qr, r32, hi);
    if (edge) {
#pragma unroll
        for (int i = 0; i < 16; ++i) { const int dist = pos - (64 * j + 32 * HALF + crow(i, hi)); p[i] = (dist >= 0 && dist < 512) ? p[i] : NEGM; }
    }
    softmax_update(p, m, l, o);
    pv_half_lean<HALF>(o, p, vb, va);
}
__device__ __forceinline__ void nsa_unit(const bf16_t* PROJ, const bf16_t* NQROT, const bf16_t* KC, const bf16_t* VC, bf16_t* ATT, int b, int g, int tt, LAS unsigned char* lds, int tid) {
    const int w = __builtin_amdgcn_readfirstlane(tid >> 6), lane = tid & 63, r32 = lane & 31, hi = lane >> 5;
    const int r = w >> 1, tokl = 32 * (w & 1) + r32, head = 4 * g + r;
    const int pos = 64 * tt + tokl;
    const size_t tok = (size_t)(b * SEQ + pos);
    bf16_t* orow = ATT + tok * D + 1024 + head * 128;
    const bf16_t* gatep = PROJ + tok * AB_PAD + 5632 + head * 3;
    const unsigned lbase = (unsigned)(uintptr_t)lds;
    LAS float* IMPH = (LAS float*)(lds + IMPH_OFF);
    LAS float* IMPF = (LAS float*)lds;
    LAS unsigned long long* SELM = (LAS unsigned long long*)(lds + SELM_OFF);
    LAS unsigned long long* UNI8 = (LAS unsigned long long*)(lds + MISC_OFF + 512);
    bf16x8 qr[8]; f32x16 o[4]; KVStage st; float m, l;
    __syncthreads();
    {
        q_load(qr, PROJ + tok * AB_PAD + 3072 + head * 128, hi);
        VAddr va; vaddr_init(va, lane);
        const bf16_t* Kh = KC + (size_t)(b * 2 + g) * 256 * 128; const bf16_t* Vh = VC + (size_t)(b * 2 + g) * 256 * 128;
        const int nmax = (pos >= 31) ? ((pos - 31) >> 4) : -1;
        m = M_INIT; l = 0.f;
        { int tid1 = tid; asm volatile("" : "+v"(tid1)); const int r0 = tid1 >> 4, c = (tid1 & 15) * 8;
#pragma unroll
          for (int tb = 0; tb < 4; tb += 2) { u32x4 ka[2][2];
#pragma unroll
              for (int t = 0; t < 2; ++t) { ka[t][0] = *(const u32x4*)(Kh + (size_t)((tb + t) * 64 + r0) * 128 + c); ka[t][1] = *(const u32x4*)(Kh + (size_t)((tb + t) * 64 + r0 + 32) * 128 + c); }
#pragma unroll
              for (int t = 0; t < 2; ++t) { *(LAS u32x4*)(lds + (tb + t) * KVB + offb(r0, tid1 & 15)) = ka[t][0]; *(LAS u32x4*)(lds + (tb + t) * KVB + offb(r0 + 32, tid1 & 15)) = ka[t][1]; } } }
        __syncthreads();
#pragma unroll
        for (int t = 0; t < 4; ++t) {
            cmp_stats_half<0>(m, l, qr, lds + t * KVB, t, nmax, r32, hi);
            cmp_stats_half<1>(m, l, qr, lds + t * KVB, t, nmax, r32, hi);
        }
        __syncthreads();
        int buf = 0;
        const float inv_l = (l > 0.f) ? 1.0f / l : 0.f; const float mc = -m * SM_C;
        O_ZERO(o);
        kv_load(st, Kh, Vh, 128, tid); kv_write(st, lds + KB0, lds + VB0, tid);
        __syncthreads();
        buf = 0; float prevT = 0.f;
        for (int t = 0; t < 4; ++t) {
            if (t + 1 < 4) kv_load(st, Kh + (size_t)(t + 1) * 64 * 128, Vh + (size_t)(t + 1) * 64 * 128, 128, tid);
            cmp_acc_half<0>(o, prevT, qr, lds + KB0 + buf * KVB, lbase + VB0 + buf * KVB, va, IMPH, t, nmax, mc, inv_l, r, tokl, r32, hi);
            cmp_acc_half<1>(o, prevT, qr, lds + KB0 + buf * KVB, lbase + VB0 + buf * KVB, va, IMPH, t, nmax, mc, inv_l, r, tokl, r32, hi);
            if (t + 1 < 4) kv_write(st, lds + KB0 + (buf ^ 1) * KVB, lds + VB0 + (buf ^ 1) * KVB, tid);
            __syncthreads();
            buf ^= 1;
        }
        o_store<false>(o, inv_l * sigmoid_f(bf2f(gatep[0])), orow, hi);
        int tid3 = tid; asm volatile("" : "+v"(tid3));
#pragma unroll
        for (int i = 0; i < 8; ++i) { const int e = tid3 + NTHREADS * i, tl = e & 63, a = e >> 6;
            IMPF[tl * 65 + a] = ((IMPH[(0 * 64 + a) * 64 + tl] + IMPH[(1 * 64 + a) * 64 + tl]) + IMPH[(2 * 64 + a) * 64 + tl]) + IMPH[(3 * 64 + a) * 64 + tl]; }
        __syncthreads();
        unsigned long long uni = 0ull;
        for (int i = 0; i < 8; ++i) {
            const int tl = 8 * w + i; const float v = IMPF[tl * 65 + lane];
            const bool forced = (lane == 0) || (lane == tt) || (lane == tt - 1);
            const bool valid = lane <= tt;
            const unsigned key = !valid ? 0u : (forced ? 0x7f000000u : (__float_as_uint(fmaxf(v, 0.f)) + 1u));
            unsigned T = 0u;
#pragma unroll 4
            for (int bit = 30; bit >= 0; --bit) { const unsigned cand = T | (1u << bit); if (__popcll(__ballot(key >= cand)) >= 16) T = cand; }
            const unsigned long long gt = __ballot(key > T);
            unsigned long long ties = __ballot(key == T && valid);
            int need = 16 - __popcll(gt); unsigned long long pick = 0ull;
            while (need > 0 && ties) { const unsigned long long low = ties & (0ull - ties); pick |= low; ties ^= low; --need; }
            const unsigned long long msk = gt | pick;
            if (lane == 0) SELM[tl] = msk;
            uni |= msk;
        }
        if (lane == 0) UNI8[w] = uni;
        __syncthreads();
    }
    int tid2 = tid; asm volatile("" : "+v"(tid2));
    const int lane2 = tid2 & 63, r32b = lane2 & 31, hib = lane2 >> 5, tokl2 = 32 * (w & 1) + r32b, pos2 = 64 * tt + tokl2;
    const size_t tok2 = (size_t)(b * SEQ + pos2);
    bf16_t* orow2 = ATT + tok2 * D + 1024 + head * 128;
    const bf16_t* gatep2 = PROJ + tok2 * AB_PAD + 5632 + head * 3;
    VAddr va; vaddr_init(va, lane2);
    const unsigned long long selm = SELM[tokl2];
    unsigned long long umask = 0ull;
#pragma unroll
    for (int i = 0; i < 8; ++i) umask |= UNI8[i];
    umask = ((unsigned long long)(unsigned)__builtin_amdgcn_readfirstlane((unsigned)(umask >> 32)) << 32) | (unsigned)__builtin_amdgcn_readfirstlane((unsigned)umask);
    q_load(qr, NQROT + tok2 * 1024 + head * 128, hib);
    const unsigned doff = kv_dma_off(w, lane2, AB_PAD * 2);
    {
        const bf16_t* Kh = PROJ + (size_t)(b * SEQ) * AB_PAD + 4608 + g * 128; const bf16_t* Vh = PROJ + (size_t)(b * SEQ) * AB_PAD + 4864 + g * 128;
        O_ZERO(o); m = M_INIT; l = 0.f;
        int jf = 0; while (jf < tt && !((umask >> jf) & 1ull)) ++jf;
        ring_attention(o, m, l, qr, va, lds, lbase, lane2, jf, tt,
            [&](int j) { int n = j + 1; while (n < tt && !((umask >> n) & 1ull)) ++n; return n < tt ? n : tt; },
            [&](int j, int stage) { kv_dma_to(Kh + (size_t)j * 64 * AB_PAD, Vh + (size_t)j * 64 * AB_PAD, doff, 32 * AB_PAD * 2, lds + R4K0 + stage * KVR + 1024 * w, lds + R4V0 + stage * KVR + 1024 * w); },
            [&](int j, int half, f32x16& p) {
                if (j == tt) {
                    const int lim = tokl2 - 32 * half - 4 * hib;
#pragma unroll
                    for (int i = 0; i < 16; ++i) p[i] = (((i & 3) + 8 * (i >> 2)) <= lim) ? p[i] : NEGM; }
                return (bool)((selm >> j) & 1ull); });
        o_store<true>(o, __builtin_amdgcn_rcpf(l) * sigmoid_f(bf2f(gatep2[1])), orow2, hib);
    }
    __syncthreads();
    {
        const bf16_t* Kh = PROJ + (size_t)(b * SEQ) * AB_PAD + 5120 + g * 128; const bf16_t* Vh = PROJ + (size_t)(b * SEQ) * AB_PAD + 5376 + g * 128;
        O_ZERO(o); m = M_INIT; l = 0.f;
        const int j0 = (tt >= 8) ? tt - 8 : 0;
        ring_attention(o, m, l, qr, va, lds, lbase, lane2, j0, tt,
            [&](int j) { return j < tt ? j + 1 : tt; },
            [&](int j, int stage) { kv_dma_to(Kh + (size_t)j * 64 * AB_PAD, Vh + (size_t)j * 64 * AB_PAD, doff, 32 * AB_PAD * 2, lds + R4K0 + stage * KVR + 1024 * w, lds + R4V0 + stage * KVR + 1024 * w); },
            [&](int j, int half, f32x16& p) {
                if ((j == tt) || (j == tt - 8)) {
#pragma unroll
                    for (int i = 0; i < 16; ++i) { const int dist = pos2 - (64 * j + 32 * half + crow(i, hib)); p[i] = (dist >= 0 && dist < 512) ? p[i] : NEGM; } }
                return true; });
        o_store<true>(o, __builtin_amdgcn_rcpf(l) * sigmoid_f(bf2f(gatep2[2])), orow2, hib);
    }
}

__device__ __forceinline__ void phase_conv_fixup(const bf16_t* UH, const float* cw  , const float* cb  , bf16_t* ACT, int gtid, int ngt) {
    constexpr int NCH = DFF / 8;
    const int nitems = (M / 256) * NCH;
    for (int it = gtid; it < nitems; it += ngt) {
        const int pm = it / NCH, ch = it - pm * NCH, n0 = 8 * ch;
        if ((pm & 15) == 0) continue;
        float g[4][8], v[4][8];
        unpack8(*(const u32x4*)(UH + ((size_t)(pm - 1) * 4 + 2) * DFF2 + n0), g[0]); unpack8(*(const u32x4*)(UH + ((size_t)(pm - 1) * 4 + 3) * DFF2 + n0), g[1]);
        unpack8(*(const u32x4*)(UH + ((size_t)pm * 4 + 0) * DFF2 + n0), g[2]); unpack8(*(const u32x4*)(UH + ((size_t)pm * 4 + 1) * DFF2 + n0), g[3]);
        unpack8(*(const u32x4*)(UH + ((size_t)(pm - 1) * 4 + 2) * DFF2 + DFF + n0), v[0]); unpack8(*(const u32x4*)(UH + ((size_t)(pm - 1) * 4 + 3) * DFF2 + DFF + n0), v[1]);
        unpack8(*(const u32x4*)(UH + ((size_t)pm * 4 + 0) * DFF2 + DFF + n0), v[2]); unpack8(*(const u32x4*)(UH + ((size_t)pm * 4 + 1) * DFF2 + DFF + n0), v[3]);
#pragma unroll
        for (int r = 0; r < 2; ++r) { float a[8];
#pragma unroll
            for (int j = 0; j < 8; ++j) {
                const float cg = cb[n0 + j] + cw[n0 + j] * g[r][j] + cw[DFF2 + n0 + j] * g[r + 1][j] + cw[2 * DFF2 + n0 + j] * g[r + 2][j];
                const float cv = cb[DFF + n0 + j] + cw[DFF + n0 + j] * v[r][j] + cw[DFF2 + DFF + n0 + j] * v[r + 1][j] + cw[2 * DFF2 + DFF + n0 + j] * v[r + 2][j];
                a[j] = silu_f(cg) * cv; }
            *(u32x4*)(ACT + (size_t)(256 * pm + r) * DFF + n0) = packu8(a); }
    }
}

__device__ __forceinline__ void retention_unit(const bf16_t* PROJ, bf16_t* Y, int b, int h, int vs, LAS unsigned char* lds, int tid) {
    const int w = __builtin_amdgcn_readfirstlane(tid >> 6);
    const int nb = (w < 4) ? (w >> 1) : (3 - ((w - 4) >> 1)), jv = w & 1;
    const int tid_in = tid;
    const float lg = log2f(1.0f - exp2f(-5.0f - (float)h));
    const float gC = exp2f(128.0f * lg);
    LAS unsigned char* Kl = lds; LAS unsigned char* Vl = lds + 65536; LAS unsigned char* Pl = lds + 81920; LAS unsigned char* Sl = lds + 114688;
    const unsigned KlA = (unsigned)(uintptr_t)Kl, VlA = (unsigned)(uintptr_t)Vl;
    const bf16_t* base = PROJ + (size_t)(b * SEQ) * C_COLS;
    f32x16 st[2];
#pragma unroll
    for (int i = 0; i < 16; ++i) { st[0][i] = 0.f; st[1][i] = 0.f; }
    u32x4 kst[8], vst[2]; bf16x8 qf[16];
    { int tid = tid_in; asm volatile("" : "+v"(tid)); const int lane = tid & 63, r32 = lane & 31, hi = lane >> 5;
#pragma unroll
    for (int i = 0; i < 8; ++i) { const int e = tid + NTHREADS * i, row = e >> 5, c32 = e & 31; kst[i] = *(const u32x4*)(base + (size_t)row * C_COLS + 2048 + h * 256 + 8 * c32); }
#pragma unroll
    for (int i = 0; i < 2; ++i) { const int e = tid + NTHREADS * i, row = e >> 3, ch = e & 7; vst[i] = *(const u32x4*)(base + (size_t)row * C_COLS + 4096 + h * 512 + 64 * vs + 8 * ch); }
#pragma unroll
    for (int s = 0; s < 16; ++s) qf[s] = *(const bf16x8*)(base + (size_t)(32 * nb + r32) * C_COLS + h * 256 + 16 * s + 8 * hi);
    }
    __syncthreads();
    for (int c = 0; c < 32; ++c) {
        int tid = tid_in; asm volatile("" : "+v"(tid));
        const int lane = tid & 63, r32 = lane & 31, hi = lane >> 5;
        const unsigned tq = (lane & 15) >> 2, tp = lane & 3, tblk = (lane >> 4) & 1;
        const bf16_t* cb = base + (size_t)(128 * c) * C_COLS;
#pragma unroll
        for (int i = 0; i < 8; ++i) { const unsigned e = tid + NTHREADS * i, row = e >> 5, c32 = e & 31; *(LAS u32x4*)(Kl + (c32 >> 4) * 32768 + offb(row, c32 & 15)) = kst[i]; }
#pragma unroll
        for (int i = 0; i < 2; ++i) { const unsigned e = tid + NTHREADS * i, row = e >> 3, ch = e & 7; float x[8]; unpack8(vst[i], x); const float kd = fast_exp2((float)(127 - (int)row) * lg);
#pragma unroll
            for (int j = 0; j < 8; ++j) x[j] *= kd;
            *(LAS u32x4*)(Vl + offv(row, ch)) = packu8(x); }
        asm volatile("s_waitcnt lgkmcnt(0)" ::: "memory"); __builtin_amdgcn_s_barrier(); asm volatile("" ::: "memory");
        if (c + 1 < 32) {
            const bf16_t* nbp = cb + (size_t)128 * C_COLS;
#pragma unroll
            for (int i = 0; i < 8; ++i) { const int e = tid + NTHREADS * i, row = e >> 5, c32 = e & 31; kst[i] = *(const u32x4*)(nbp + (size_t)row * C_COLS + 2048 + h * 256 + 8 * c32); }
#pragma unroll
            for (int i = 0; i < 2; ++i) { const int e = tid + NTHREADS * i, row = e >> 3, ch = e & 7; vst[i] = *(const u32x4*)(nbp + (size_t)row * C_COLS + 4096 + h * 512 + 64 * vs + 8 * ch); }
        }
        {
            const int mb0 = (nb == 1) ? jv : 2 * jv, mb1 = (nb == 1) ? 4 : 2 * jv + 1;
            if (mb0 <= nb) {
                const bool two = (mb1 <= nb);
                f32x16 sa0, sa1;
#pragma unroll
                for (int i = 0; i < 16; ++i) { sa0[i] = 0.f; sa1[i] = 0.f; }
                if (two) {
#pragma unroll
                    for (int s = 0; s < 16; ++s) {
                        const bf16x8 kf0 = *(LAS const bf16x8*)(Kl + (s >> 3) * 32768 + offb(32 * mb0 + r32, 2 * (s & 7) + hi));
                        const bf16x8 kf1 = *(LAS const bf16x8*)(Kl + (s >> 3) * 32768 + offb(32 * mb1 + r32, 2 * (s & 7) + hi));
                        sa0 = MFMA32(qf[s], kf0, sa0); sa1 = MFMA32(qf[s], kf1, sa1);
                    }
                } else {
#pragma unroll
                    for (int s = 0; s < 16; ++s) {
                        const bf16x8 kf0 = *(LAS const bf16x8*)(Kl + (s >> 3) * 32768 + offb(32 * mb0 + r32, 2 * (s & 7) + hi));
                        sa0 = MFMA32(qf[s], kf0, sa0);
                    }
                }
                const int mc0 = 32 * mb0 + r32, mc1 = 32 * mb1 + r32;
#pragma unroll
                for (int j = 0; j < 4; ++j) { const int n0 = 32 * nb + 8 * j + 4 * hi; float x0[4], x1[4];
#pragma unroll
                    for (int e = 0; e < 4; ++e) { const int n = n0 + e; const float f = fast_exp2((float)(n - 127) * lg);
                        x0[e] = (mc0 <= n) ? sa0[4 * j + e] * f : 0.f; x1[e] = (mc1 <= n) ? sa1[4 * j + e] * f : 0.f; }
                    { u32x2 pk; pk.x = cvtpk(x0[0], x0[1]); pk.y = cvtpk(x0[2], x0[3]); *(LAS u32x2*)(Pl + offb(mc0, 4 * nb + j) + 8 * hi) = pk; }
                    if (two) { u32x2 pk; pk.x = cvtpk(x1[0], x1[1]); pk.y = cvtpk(x1[2], x1[3]); *(LAS u32x2*)(Pl + offb(mc1, 4 * nb + j) + 8 * hi) = pk; } }
            }
        }

        f32x16 oacc;
#pragma unroll
        for (int i = 0; i < 16; ++i) oacc[i] = 0.f;
        if (c > 0) {
#pragma unroll
            for (int s = 0; s < 16; ++s) {
                const bf16x8 sf = *(LAS const bf16x8*)(Sl + (s >> 3) * 16384 + offb(32 * jv + r32, 2 * (s & 7) + hi));
                oacc = MFMA32(qf[s], sf, oacc);
            }
#pragma unroll
            for (int i = 0; i < 16; ++i) oacc[i] *= fast_exp2((float)(32 * nb + crow(i, hi) + 1) * lg);
        }
        if (c + 1 < 32) {
            const bf16_t* nbp = cb + (size_t)128 * C_COLS;
#pragma unroll
            for (int s = 0; s < 16; ++s) qf[s] = *(const bf16x8*)(nbp + (size_t)(32 * nb + r32) * C_COLS + h * 256 + 16 * s + 8 * hi);
        }
        asm volatile("s_waitcnt lgkmcnt(0)" ::: "memory"); __builtin_amdgcn_s_barrier(); asm volatile("" ::: "memory");
        for (int mb = 0; mb <= nb; ++mb) {
#pragma unroll
            for (int s2 = 0; s2 < 2; ++s2) {
                const unsigned row0 = 32 * mb + 16 * s2 + 8 * hi + tq, chv = 4 * jv + 2 * tblk + (tp >> 1), chp = 4 * nb + 2 * tblk + (tp >> 1);
                const unsigned PlA = (unsigned)(uintptr_t)Pl;
                const s16x4 plo = tr_read0(PlA + offb(row0, chp) + 8 * (tp & 1)), phi = tr_read0(PlA + offb(row0 + 4, chp) + 8 * (tp & 1));
                const bf16x8 pf = PK8(plo, phi);
                const s16x4 lo = tr_read0(VlA + offv(row0, chv) + 8 * (tp & 1)), hh = tr_read0(VlA + offv(row0 + 4, chv) + 8 * (tp & 1));
                LGKM_WAIT0();
                oacc = MFMA32(pf, PK8(lo, hh), oacc);
            }
        }
        { bf16_t* yo = Y + (size_t)(b * SEQ + 128 * c + 32 * nb) * 4096 + h * 512 + 64 * vs + 32 * jv + r32;
#pragma unroll
          for (int i = 0; i < 16; ++i) yo[(size_t)crow(i, hi) * 4096] = f2bf(oacc[i]); }

#pragma unroll
        for (int vb = 0; vb < 2; ++vb) {
#pragma unroll
            for (int i = 0; i < 16; ++i) st[vb][i] *= gC;
        }
#pragma unroll
        for (int s2 = 0; s2 < 4; ++s2) {
            const unsigned chk = 4 * (w & 3) + 2 * tblk + (tp >> 1), cv0 = 2 * tblk + (tp >> 1), cv1 = 4 + 2 * tblk + (tp >> 1), kb_ = KlA + (w >> 2) * 32768 + 8 * (tp & 1), vb_ = VlA + 8 * (tp & 1);
            const unsigned ra = 32 * s2 + 8 * hi + tq, rb = ra + 16;
            const s16x4 kal = tr_read0(kb_ + offb(ra, chk)), kah = tr_read0(kb_ + offb(ra + 4, chk)), kbl = tr_read0(kb_ + offb(rb, chk)), kbh = tr_read0(kb_ + offb(rb + 4, chk));
            const s16x4 a0l = tr_read0(vb_ + offv(ra, cv0)), a0h = tr_read0(vb_ + offv(ra + 4, cv0)), a1l = tr_read0(vb_ + offv(ra, cv1)), a1h = tr_read0(vb_ + offv(ra + 4, cv1));
            const s16x4 b0l = tr_read0(vb_ + offv(rb, cv0)), b0h = tr_read0(vb_ + offv(rb + 4, cv0)), b1l = tr_read0(vb_ + offv(rb, cv1)), b1h = tr_read0(vb_ + offv(rb + 4, cv1));
            LGKM_WAIT0();
            const bf16x8 kfa = PK8(kal, kah), kfb = PK8(kbl, kbh);
            st[0] = MFMA32(kfa, PK8(a0l, a0h), st[0]); st[1] = MFMA32(kfa, PK8(a1l, a1h), st[1]);
            st[0] = MFMA32(kfb, PK8(b0l, b0h), st[0]); st[1] = MFMA32(kfb, PK8(b1l, b1h), st[1]);
        }
#pragma unroll
        for (int vb = 0; vb < 2; ++vb)
#pragma unroll
            for (int g = 0; g < 4; ++g) {
                const unsigned dd = (32 * (w & 3) + 8 * g + 4 * hi);
                u32x2 pk; pk.x = cvtpk(st[vb][4 * g], st[vb][4 * g + 1]); pk.y = cvtpk(st[vb][4 * g + 2], st[vb][4 * g + 3]);
                *(LAS u32x2*)(Sl + (w >> 2) * 16384 + offb(32 * vb + r32, dd >> 3) + 2 * (dd & 7)) = pk;
            }
        asm volatile("s_waitcnt lgkmcnt(0)" ::: "memory"); __builtin_amdgcn_s_barrier(); asm volatile("" ::: "memory");
    }
}

__device__ __forceinline__ void phase_gn_gate(bf16_t* Y, const bf16_t* PROJ, const float* gn  , int gw, int ngw, int lane) {
    int rid = gw;
    for (; rid + 3 * ngw < M * 8; rid += 4 * ngw) {
        u32x4 yr[4], gr[4];
#pragma unroll
        for (int k = 0; k < 4; ++k) { const int r = rid + k * ngw, tok = r >> 3, head = r & 7;
            yr[k] = *(const u32x4*)(Y + (size_t)tok * 4096 + head * 512 + 8 * lane); gr[k] = *(const u32x4*)(PROJ + (size_t)tok * C_COLS + 8192 + head * 512 + 8 * lane); }
#pragma unroll
        for (int k = 0; k < 4; ++k) { const int r = rid + k * ngw, tok = r >> 3, head = r & 7;
            float y[8], gg[8]; unpack8(yr[k], y); unpack8(gr[k], gg);
            float s = 0.f;
#pragma unroll
            for (int j = 0; j < 8; ++j) s += y[j];
            const float mu = wave_sum(s) * (1.0f / 512.0f); float q = 0.f;
#pragma unroll
            for (int j = 0; j < 8; ++j) { y[j] -= mu; q += y[j] * y[j]; }
            const float rstd = 1.0f / sqrtf(wave_sum(q) * (1.0f / 512.0f) + RMS_EPS);
            const f32x4 n0 = *(const f32x4*)(gn + head * 512 + 8 * lane), n1 = *(const f32x4*)(gn + head * 512 + 8 * lane + 4);
            const float nn[8] = {n0.x, n0.y, n0.z, n0.w, n1.x, n1.y, n1.z, n1.w};
#pragma unroll
            for (int j = 0; j < 8; ++j) y[j] = silu_f(gg[j]) * (y[j] * rstd * nn[j]);
            *(u32x4*)(Y + (size_t)tok * 4096 + head * 512 + 8 * lane) = packu8(y); }
    }
    for (; rid < M * 8; rid += ngw) {
        const int tok = rid >> 3, head = rid & 7;
        bf16_t* yp = Y + (size_t)tok * 4096 + head * 512 + 8 * lane;
        float y[8], gg[8]; unpack8(*(const u32x4*)yp, y); unpack8(*(const u32x4*)(PROJ + (size_t)tok * C_COLS + 8192 + head * 512 + 8 * lane), gg);
        float s = 0.f;
#pragma unroll
        for (int j = 0; j < 8; ++j) s += y[j];
        const float mu = wave_sum(s) * (1.0f / 512.0f); float q = 0.f;
#pragma unroll
        for (int j = 0; j < 8; ++j) { y[j] -= mu; q += y[j] * y[j]; }
        const float rstd = 1.0f / sqrtf(wave_sum(q) * (1.0f / 512.0f) + RMS_EPS);
        const f32x4 n0 = *(const f32x4*)(gn + head * 512 + 8 * lane), n1 = *(const f32x4*)(gn + head * 512 + 8 * lane + 4);
        const float nn[8] = {n0.x, n0.y, n0.z, n0.w, n1.x, n1.y, n1.z, n1.w};
#pragma unroll
        for (int j = 0; j < 8; ++j) y[j] = silu_f(gg[j]) * (y[j] * rstd * nn[j]);
        *(u32x4*)yp = packu8(y);
    }
}


template <class... T> __device__ __forceinline__ void sk_nop(T...) {}
#ifdef SKIP_CMP
#define SK_CMP(f) sk_nop
#else
#define SK_CMP(f) f
#endif
#ifdef SKIP_MPREP
#define SK_MPREP(f) sk_nop
#else
#define SK_MPREP(f) f
#endif
#ifdef SKIP_NSA
#define SK_NSA(f) sk_nop
#else
#define SK_NSA(f) f
#endif
#ifdef SKIP_MOBA
#define SK_MOBA(f) sk_nop
#else
#define SK_MOBA(f) f
#endif
#ifdef SKIP_RET
#define SK_RET(f) sk_nop
#else
#define SK_RET(f) f
#endif
#ifdef SKIP_CROSS
#define SK_CROSS(f) sk_nop
#else
#define SK_CROSS(f) f
#endif
#ifdef SKIP_CONV
#define SK_CONV(f) sk_nop
#else
#define SK_CONV(f) f
#endif
#ifdef SKIP_GN
#define SK_GN(f) sk_nop
#else
#define SK_GN(f) f
#endif
#ifdef SKIP_GEMM
#define SK_GEMM if (0)
#else
#define SK_GEMM
#endif
__device__ __forceinline__ int launder_v(int x) { asm volatile("" : "+v"(x)); return x; }
__device__ __forceinline__ int launder_s(int x) { asm volatile("" : "+s"(x)); return x; }
__device__ __forceinline__ unsigned char* launder_p(unsigned char* p) { GAS unsigned char* g = (GAS unsigned char*)p; asm volatile("" : "+s"(g)); return (unsigned char*)g; }
#ifndef MK_DUP
#define MK_DUP 0
#endif
#define DUPN(bit) (1 + ((MK_DUP >> (bit)) & 1))
struct Args { const float* in[26]; float* out; unsigned char* ws; int ph_lo, ph_hi; };

__global__ void __launch_bounds__(NTHREADS, 2) fwd_kernel(Args args) {
    extern __shared__ __attribute__((aligned(16))) unsigned char lds_raw[];
    LAS unsigned char* lds = (LAS unsigned char*)lds_raw;
    const int tid0 = threadIdx.x; const int wave0 = __builtin_amdgcn_readfirstlane(tid0 >> 6);
    const int G = gridDim.x, bid = blockIdx.x;
    const int ngw = G * NWAVES, ngt = G * NTHREADS;
    unsigned char* ws0 = args.ws;
    volatile LAS unsigned* MISC = (volatile LAS unsigned*)(lds + MISC_OFF);
    for (int u = tid0; u < 256; u += NTHREADS) MISC[u] = 0u;
    __syncthreads();
    const int lo = args.ph_lo, hi_ph = args.ph_hi;
    XcdBarrier bar; bar.bar = (unsigned*)(ws0 + WS_CTL) + CW_BAR; bar.x = 0; bar.st = nullptr; bar.lead = 0;
    if (hi_ph - lo > 1) bar = xcd_barrier_post((unsigned*)(ws0 + WS_CTL) + CW_BAR, MISC + 8);
#define IN(k) (lo <= (k) && (k) < hi_ph)
#define SEAM(k) do { if (IN(k) && IN((k) + 1)) { XcdBarrier b2_ = bar; b2_.bar = (unsigned*)launder_p((unsigned char*)bar.bar); b2_.x = (unsigned)launder_s((int)bar.x); b2_.lead = (launder_s(wave0) == 0) && ((int)__builtin_amdgcn_mbcnt_hi(~0u, __builtin_amdgcn_mbcnt_lo(~0u, (unsigned)launder_v(0))) == 0); xcd_barrier(b2_); if (DUPN(9) > 1) xcd_barrier(b2_); } } while (0)
#define PHASE_VARS const int lane = (int)__builtin_amdgcn_mbcnt_hi(~0u, __builtin_amdgcn_mbcnt_lo(~0u, (unsigned)launder_v(0))); const int wave = launder_s(wave0); const int tid = wave * 64 + lane; \
    const int gw = bid * NWAVES + wave, gtid = bid * NTHREADS + tid; unsigned char* ws = launder_p(ws0); (void)lane; (void)gw; (void)gtid; (void)ws;

    if (IN(PH_G0)) {
        PHASE_VARS
        LAS float* scr = (LAS float*)(lds + wave * 16640);
        for (int rep = 0; rep < DUPN(4); ++rep) {
        int base = 0;
        for (int e = 0; e < 2; ++e) {
            transpose_matrix(args.in[8] + (size_t)e * 2048 * AB_COLS, args.in[3] + (2 * e) * D, 2048, AB_COLS, AB_PAD, (bf16_t*)(ws + WS_WINAB + e * 23 * MiB), scr, gw, ngw, lane, base);
            transpose_matrix(args.in[15] + (size_t)e * 2048 * 2048, nullptr, 2048, 2048, 2048, (bf16_t*)(ws + WS_WOUTAB + e * 8 * MiB), scr, gw, ngw, lane, base);
            transpose_matrix(args.in[10] + (size_t)e * 4096 * 128, nullptr, 4096, 128, 128, (bf16_t*)(ws + WS_W1K + e * MiB), scr, gw, ngw, lane, base, false, true);
            transpose_matrix(args.in[13] + (size_t)e * 4096 * 128, nullptr, 4096, 128, 128, (bf16_t*)(ws + WS_W1V + e * MiB), scr, gw, ngw, lane, base, false, true);
            transpose_matrix(args.in[11] + (size_t)e * 128 * 128, nullptr, 128, 128, 128, (bf16_t*)(ws + WS_W2K + e * 32768), scr, gw, ngw, lane, base);
            transpose_matrix(args.in[14] + (size_t)e * 128 * 128, nullptr, 128, 128, 128, (bf16_t*)(ws + WS_W2V + e * 32768), scr, gw, ngw, lane, base);
            transpose_matrix(args.in[16] + (size_t)e * 2048 * C_COLS, args.in[3] + (2 * e + 1) * D, 2048, C_COLS, C_COLS, (bf16_t*)(ws + WS_WINC + e * 48 * MiB), scr, gw, ngw, lane, base);
            transpose_matrix(args.in[18] + (size_t)e * 4096 * 2048, nullptr, 4096, 2048, 2048, (bf16_t*)(ws + WS_WOUTC + e * 16 * MiB), scr, gw, ngw, lane, base);
        }
        for (int l = 0; l < 4; ++l) {
            transpose_matrix(args.in[19] + (size_t)l * 2048 * 512, args.in[4] + l * D, 2048, 512, 512, (bf16_t*)(ws + WS_WQX + l * 2 * MiB), scr, gw, ngw, lane, base);
            transpose_matrix(args.in[20] + (size_t)l * 2048 * 1024, nullptr, 2048, 1024, 1024, (bf16_t*)(ws + WS_WKVALL + l * 4 * MiB), scr, gw, ngw, lane, base);
            transpose_matrix(args.in[21] + (size_t)l * 512 * 2048, nullptr, 512, 2048, 2048, (bf16_t*)(ws + WS_WOX + l * 2 * MiB), scr, gw, ngw, lane, base);
            transpose_matrix(args.in[22] + (size_t)l * 2048 * DFF2, args.in[5] + l * D, 2048, DFF2, DFF2, (bf16_t*)(ws + WS_WUP + l * 44 * MiB), scr, gw, ngw, lane, base, true);
            if (l == 0) transpose_matrix(args.in[25] + (size_t)l * DFF * 2048, nullptr, DFF, 2048, 2048, (bf16_t*)(ws + WS_WDOWN + l * 22 * MiB), scr, gw, ngw, lane, base);
        }
        for (int m = gw; m < BATCH * 256; m += ngw) rms_row_bf16(args.in[1] + (size_t)m * D, args.in[6], (bf16_t*)(ws + WS_MEMN) + (size_t)m * D, lane);
        { float* SSP = (float*)(ws + WS_SSP);
          for (int m = gw; m < M; m += ngw) { const float ss = row_to_bf16_ss(args.in[0] + (size_t)m * D, (bf16_t*)(ws + WS_HN) + (size_t)m * D, lane);
              if (lane < 8) SSP[(size_t)lane * M + m] = (lane == 0) ? ss : 0.f; } }
        }
    }
    SEAM(PH_G0);
    for (int layer0 = 0; layer0 < DEPTH; ++layer0) {
        const int layer = launder_s(layer0);
        const int pb = PH_L0 + layer * PH_PER_LAYER;
        const int eo = layer >> 1;
        const bool odd = layer & 1;
        if (IN(pb)) {
            PHASE_VARS
            const int N = odd ? C_COLS : AB_PAD;
            const bf16_t* Wt = odd ? (const bf16_t*)(ws + WS_WINC + eo * 48 * MiB) : (const bf16_t*)(ws + WS_WINAB + eo * 23 * MiB);
            pg8::Gemm g{(const bf16_t*)(ws + WS_HN), Wt, M, N, 2048}; pg8::StaticOrder S; S.init(M, N, G, bid);
            pg8::EpiStoreN E{(bf16_t*)(ws + WS_R1), N, (const float*)(ws + WS_SSP), M, (const int*)args.in[2], odd ? 1 : 2, (bf16_t*)(ws + WS_NQROT)};
            for (int rep = 0; rep < DUPN(6); ++rep) SK_GEMM pg8::gemm_phase<pg8::EpiStoreN, pg8::StaticOrder, true, true>(lds, g, S, E, tid);
            if (layer == 0 && bid >= G - 64) {
                __syncthreads();
                pg8::Gemm g2{(const bf16_t*)(ws + WS_MEMN), (const bf16_t*)(ws + WS_WKVALL), BATCH * 256, 4096, 2048}; pg8::StaticOrder S2; S2.init(BATCH * 256, 4096, 64, bid - (G - 64));
                pg8::EpiStore E2{(bf16_t*)(ws + WS_MEMKV), 4096};
                SK_GEMM pg8::gemm_phase<pg8::EpiStore, pg8::StaticOrder, true, true>(lds, g2, S2, E2, tid);
            }
        }
        SEAM(pb);
        if (!odd) {
            if (IN(pb + 1)) {
                PHASE_VARS
                const bf16_t* PROJ = (const bf16_t*)(ws + WS_R1);
                for (int rep = 0; rep < DUPN(7); ++rep)
                for (int it = bid; it < 640; it += G) {
                    if (it < 128) {
                        const int rb = it & 7, gg = (it >> 3) & 1, b = (it >> 4) & 3, tensor = it >> 6;
                        SK_CMP(compress_item)(PROJ, args.in[tensor ? 12 : 9] + (size_t)eo * 32 * 128, (const bf16_t*)(ws + (tensor ? WS_W1V : WS_W1K) + eo * MiB),
                                      (const bf16_t*)(ws + (tensor ? WS_W2V : WS_W2K) + eo * 32768), (bf16_t*)(ws + (tensor ? WS_VC : WS_KC)) + (size_t)(b * 2 + gg) * 256 * 128,
                                      b, gg, rb, tensor ? 4352 : 4096, lds, tid);
                    } else {
                        const int u = it - 128; SK_MPREP(moba_prep_item)(PROJ, (float*)(ws + WS_KMEAN), u >> 7, (u >> 4) & 7, u & 15, lds, tid);
                    }
                }
            }
            SEAM(pb + 1);
            if (IN(pb + 2)) {
                for (int rep = 0; rep < DUPN(2); ++rep) {
                PHASE_VARS
                unsigned* qh = (unsigned*)(ws + WS_CTL) + CW_QUEUE + 128 * eo + 32 * rep;
                bool first_ = true;
                for (;;) {
                    unsigned idx;
                    if (first_) { idx = (unsigned)bid; first_ = false; }
                    else {
                        __syncthreads();
                        if (tid == 0) MISC[16] = (unsigned)G + __hip_atomic_fetch_add(qh, 1u, __ATOMIC_RELAXED, __HIP_MEMORY_SCOPE_AGENT);
                        __syncthreads();
                        idx = MISC[16];
                    }
                    if (idx >= 512u) break;
                    SK_NSA(nsa_unit)((const bf16_t*)(ws + WS_R1), (const bf16_t*)(ws + WS_NQROT), (const bf16_t*)(ws + WS_KC), (const bf16_t*)(ws + WS_VC), (bf16_t*)(ws + WS_ATT), (int)(idx & 7u) >> 1, (int)(idx & 1u), 63 - (int)(idx >> 3), lds, tid);
                }
                }
                for (int rep = 0; rep < DUPN(8); ++rep) {
                PHASE_VARS
                unsigned* qh = (unsigned*)(ws + WS_CTL) + CW_QUEUE + 128 * eo + 64 + 32 * rep;
                bool first_ = true;
                for (;;) {
                    unsigned idx;
                    if (first_) { idx = (unsigned)bid; first_ = false; }
                    else {
                        __syncthreads();
                        if (tid == 0) MISC[17] = (unsigned)G + __hip_atomic_fetch_add(qh, 1u, __ATOMIC_RELAXED, __HIP_MEMORY_SCOPE_AGENT);
                        __syncthreads();
                        idx = MISC[17];
                    }
                    if (idx >= 512u) break;
                    SK_MOBA(moba_unit)((const bf16_t*)(ws + WS_R1), (const float*)(ws + WS_KMEAN), (bf16_t*)(ws + WS_ATT), (int)(idx & 31u) >> 3, (int)(idx & 7u), 15 - (int)(idx >> 5), lds, tid);
                }
                }
            }
            SEAM(pb + 2);
        } else {
            if (IN(pb + 1)) {
                PHASE_VARS
                for (int rep = 0; rep < DUPN(3); ++rep) for (int u = bid; u < 256; u += G) { const int bh = (u & 7) + 8 * (u >> 6), vs = (u >> 3) & 7; SK_RET(retention_unit)((const bf16_t*)(ws + WS_R1), (bf16_t*)(ws + WS_Y), bh >> 3, bh & 7, vs, lds, tid); }
            }
            SEAM(pb + 1);
            if (IN(pb + 2)) { PHASE_VARS SK_GN(phase_gn_gate)((bf16_t*)(ws + WS_Y), (const bf16_t*)(ws + WS_R1), args.in[17] + (size_t)eo * 8 * 512, gw, ngw, lane); }
            SEAM(pb + 2);
        }
        if (IN(pb + 3)) {
            PHASE_VARS
            const int K = odd ? 4096 : 2048;
            const bf16_t* A = odd ? (const bf16_t*)(ws + WS_Y) : (const bf16_t*)(ws + WS_ATT);
            const bf16_t* Wt = odd ? (const bf16_t*)(ws + WS_WOUTC + eo * 16 * MiB) : (const bf16_t*)(ws + WS_WOUTAB + eo * 8 * MiB);
            pg8::Gemm g{A, Wt, M, 2048, K}; pg8::StaticOrder S; S.init(M, 2048, G, bid);
            pg8::EpiResid3 E{(bf16_t*)(ws + WS_HN), (float*)(ws + WS_SSP), M, (LAS float*)(lds + EPI_SCR_OFF), D};
            SK_GEMM pg8::gemm_phase<pg8::EpiResid3, pg8::StaticOrder, true, true>(lds, g, S, E, tid);
        }
        SEAM(pb + 3);
        if (IN(pb + 4)) {
            PHASE_VARS
            pg8::Gemm g{(const bf16_t*)(ws + WS_HN), (const bf16_t*)(ws + WS_WQX + layer * 2 * MiB), M, 512, 2048}; pg8::StaticOrder S; S.init(M, 512, G, bid);
            pg8::EpiStoreN E{(bf16_t*)(ws + WS_QX), 512, (const float*)(ws + WS_SSP), M, nullptr, 0, nullptr};
            for (int rep = 0; rep < DUPN(6); ++rep) SK_GEMM pg8::gemm_phase<pg8::EpiStoreN, pg8::StaticOrder, true, true>(lds, g, S, E, tid);
            if (layer + 1 < DEPTH) {
                const int c0 = (G > 128) ? 128 : 0;
                if (bid >= c0) {
                    __syncthreads();
                    LAS float* scr = (LAS float*)(lds + wave * 16640); int base = 0;
                    transpose_matrix(args.in[25] + (size_t)(layer + 1) * DFF * 2048, nullptr, DFF, 2048, 2048, (bf16_t*)(ws + WS_WDOWN + (layer + 1) * 22 * MiB), scr, (bid - c0) * NWAVES + wave, (G - c0) * NWAVES, lane, base);
                }
            }
        }
        SEAM(pb + 4);
        if (IN(pb + 5)) {
            PHASE_VARS
            for (int rep = 0; rep < DUPN(5); ++rep) for (int u = bid; u < 256; u += G) SK_CROSS(cross_unit)((const bf16_t*)(ws + WS_QX), (const bf16_t*)(ws + WS_MEMKV), (bf16_t*)(ws + WS_AX), layer, u >> 6, (u >> 4) & 3, u & 15, lds, tid);
        }
        SEAM(pb + 5);
        if (IN(pb + 6)) {
            PHASE_VARS
            pg8::Gemm g{(const bf16_t*)(ws + WS_AX), (const bf16_t*)(ws + WS_WOX + layer * 2 * MiB), M, 2048, 512}; pg8::StaticOrder S; S.init(M, 2048, G, bid);
            pg8::EpiResid3 E{(bf16_t*)(ws + WS_HN), (float*)(ws + WS_SSP), M, (LAS float*)(lds + EPI_SCR_OFF), D};
            SK_GEMM pg8::gemm_phase<pg8::EpiResid3, pg8::StaticOrder, true, true>(lds, g, S, E, tid);
        }
        SEAM(pb + 6);
        if (IN(pb + 7)) {
            PHASE_VARS
            pg8::Gemm g{(const bf16_t*)(ws + WS_HN), (const bf16_t*)(ws + WS_WUP + layer * 44 * MiB), M, DFF2, 2048}; pg8::StaticOrder S; S.init(M, DFF2, G, bid);
            pg8::EpiStoreFFN E{(bf16_t*)(ws + WS_ACT), (const float*)(ws + WS_SSP), M, args.in[23] + (size_t)layer * 3 * DFF2, args.in[24] + (size_t)layer * DFF2, (bf16_t*)(ws + WS_R1), (LAS float*)(lds + EPI_SCR_OFF)};
            for (int rep = 0; rep < DUPN(6); ++rep) SK_GEMM pg8::gemm_phase<pg8::EpiStoreFFN, pg8::StaticOrder, true, true>(lds, g, S, E, tid);
        }
        SEAM(pb + 7);
        if (IN(pb + 8)) { PHASE_VARS for (int rep = 0; rep < DUPN(1); ++rep) SK_CONV(phase_conv_fixup)((const bf16_t*)(ws + WS_R1), args.in[23] + (size_t)layer * 3 * DFF2, args.in[24] + (size_t)layer * DFF2, (bf16_t*)(ws + WS_ACT), gtid, ngt); }
        SEAM(pb + 8);
        if (IN(pb + 9)) {
            PHASE_VARS
            pg8::Gemm g{(const bf16_t*)(ws + WS_ACT), (const bf16_t*)(ws + WS_WDOWN + layer * 22 * MiB), M, 2048, DFF}; pg8::StaticOrder S; S.init(M, 2048, G, bid);
            pg8::EpiResid3 E{(bf16_t*)(ws + WS_HN), (float*)(ws + WS_SSP), M, (LAS float*)(lds + EPI_SCR_OFF), D};
            SK_GEMM pg8::gemm_phase<pg8::EpiResid3, pg8::StaticOrder, true, true>(lds, g, S, E, tid);
        }
        SEAM(pb + 9);
    }
    if (IN(PH_FINAL)) { PHASE_VARS for (int m = gw; m < M; m += ngw) rms_row_bf16in_f32((const bf16_t*)(ws + WS_HN) + (size_t)m * D, args.in[7], args.out + (size_t)m * D, lane); }
#undef IN
#undef SEAM
#undef PHASE_VARS
}

#ifndef MK_PER_PHASE
#define MK_PER_PHASE 0
#endif
extern "C" void kernel_launch(void* const* d_in, const int* in_sizes, int n_in, void* d_out, int out_size, void* d_ws, size_t ws_size, hipStream_t stream) {
    static int grid = 0;
    if (grid == 0) {
        if (n_in != 26 || in_sizes[0] != M * D || out_size != M * D || ws_size < WS_END) {
            fprintf(stderr, "kernel_launch: unexpected shapes: n_in %d in0 %d out %d ws %zu (need %zu); nothing launched\n", n_in, n_in > 0 ? in_sizes[0] : -1, out_size, ws_size, (size_t)WS_END); grid = -1; return; }
        int dev = 0, cus = 0, per_cu = 0;
        if (hipGetDevice(&dev) != hipSuccess || hipDeviceGetAttribute(&cus, hipDeviceAttributeMultiprocessorCount, dev) != hipSuccess) { fprintf(stderr, "kernel_launch: device query failed\n"); grid = -1; return; }
        if (hipFuncSetAttribute((const void*)fwd_kernel, hipFuncAttributeMaxDynamicSharedMemorySize, LDS_BYTES) != hipSuccess) { fprintf(stderr, "kernel_launch: hipFuncSetAttribute(%d B LDS) failed\n", LDS_BYTES); grid = -1; return; }
        if (hipOccupancyMaxActiveBlocksPerMultiprocessor(&per_cu, (const void*)fwd_kernel, NTHREADS, LDS_BYTES) != hipSuccess || per_cu < 1)
            fprintf(stderr, "kernel_launch: note: occupancy query reports %d workgroups per CU\n", per_cu);
        (void)hipGetLastError();
        grid = cus;
    }
    if (grid < 0) return;
    if (hipMemsetAsync((char*)d_ws + WS_CTL, 0, CTL_ZERO_BYTES, stream) != hipSuccess) { fprintf(stderr, "kernel_launch: memset failed\n"); return; }
    Args a{};
    for (int i = 0; i < 26; ++i) a.in[i] = (const float*)d_in[i];
    a.out = (float*)d_out; a.ws = (unsigned char*)d_ws;
#if MK_PER_PHASE
    for (int p = 0; p < N_PHASES; ++p) { a.ph_lo = p; a.ph_hi = p + 1; hipLaunchKernelGGL(fwd_kernel, dim3(grid), dim3(NTHREADS), LDS_BYTES, stream, a); }
#else
    a.ph_lo = 0; a.ph_hi = N_PHASES; hipLaunchKernelGGL(fwd_kernel, dim3(grid), dim3(NTHREADS), LDS_BYTES, stream, a);
#endif
    const hipError_t le = hipPeekAtLastError();
    if (le != hipSuccess) fprintf(stderr, "kernel_launch: launch failed: %s\n", hipGetErrorName(le));
}
```

```cpp
#include <hip/hip_runtime.h>
#include <cstdio>
#include <cstdint>
namespace pg8 {
#define PG8_LAS __attribute__((address_space(3)))
typedef unsigned short bf16_t;
typedef short bf16x8 __attribute__((ext_vector_type(8)));
typedef float f32x4 __attribute__((ext_vector_type(4)));
typedef unsigned u32x4 __attribute__((ext_vector_type(4)));
constexpr int BM = 256, BK = 64, HALF = 128, HTB = HALF * BK * 2  , STAGE_BYTES = 8 * HTB, NXCD = 8, WGM = 8;

__host__ __device__ __forceinline__ int lds_byte(int r, int c) { const int st = (r >> 4) * 2 + (c >> 5), rr = r & 15, cc = c & 31, ob = rr * 64 + cc * 2; return st * 1024 + (ob ^ (((ob >> 9) & 1) << 5)); }
__host__ __device__ __forceinline__ void stage_rc(int b, int& R, int& C) { const int st = b / 1024, sb = b % 1024, swz = sb ^ (((sb >> 9) & 1) << 5); R = (st >> 1) * 16 + swz / 64; C = (st & 1) * 32 + (swz % 64) / 2; }
__host__ __device__ __forceinline__ int perm32(int rho) { const int n = rho >> 4, i = rho & 15; return 8 * (i >> 2) + 4 * n + (i & 3); }

struct Unit { int pm, pn; };
struct Gemm { const bf16_t* A; const bf16_t* Bt; int M, N, K; };

struct StaticOrder {
    int nM, nN, nwg, G, c;
    __host__ __device__ void init(int M, int N, int G_, int c_) { nM = M / BM; nN = N / BM; nwg = nM * nN; G = G_; c = c_; }
    __host__ __device__ bool next(int i, Unit& u) const {
        const long L = (long)i * G + c; if (L >= nwg) return false;
        int wgid = (int)L; { const int q = nwg / NXCD, r = nwg % NXCD, xcd = wgid % NXCD, off = wgid / NXCD; wgid = (xcd < r ? xcd * (q + 1) : r * (q + 1) + (xcd - r) * q) + off; }
        const int nig = WGM * nN, gid = wgid / nig, fm = gid * WGM, gsz = (nM - fm) < WGM ? (nM - fm) : WGM;
        u.pm = fm + ((wgid % nig) % gsz); u.pn = (wgid % nig) / gsz; return true;
    }
    __device__ __forceinline__ void a_ready(const Unit&) const {}
    __device__ __forceinline__ void done(const Unit&) const {}
};
typedef __bf16 bf16x2_native __attribute__((ext_vector_type(2)));
__device__ __forceinline__ unsigned cvt_pk_bf16(float lo, float hi) { bf16x2_native v; v.x = (__bf16)lo; v.y = (__bf16)hi; return __builtin_bit_cast(unsigned, v); }
struct EpiStore {
    static constexpr bool PERM = true, AFTER_DRAIN = false, PERMA = false;
    bf16_t* O; int ldc;
    __device__ __forceinline__ void operator()(const f32x4 (&acc)[2][2][4][2], const Unit& u, int wr, int wc, int fr, int fq) const {
        const int row0 = u.pm * BM + wr * 64 + fr, col0 = u.pn * BM + wc * 32 + 8 * fq;
#pragma unroll
        for (int ai = 0; ai < 2; ++ai)
#pragma unroll
            for (int m = 0; m < 4; ++m) { bf16_t* rowp = O + (size_t)(row0 + ai * HALF + m * 16) * ldc + col0;
#pragma unroll
                for (int bj = 0; bj < 2; ++bj) { const f32x4 v0 = acc[ai][bj][m][0], v1 = acc[ai][bj][m][1];
                    u32x4 w; w.x = cvt_pk_bf16(v0[0], v0[1]); w.y = cvt_pk_bf16(v0[2], v0[3]); w.z = cvt_pk_bf16(v1[0], v1[1]); w.w = cvt_pk_bf16(v1[2], v1[3]);
                    *(u32x4*)(rowp + bj * HALF) = w; } }
    }
};
__device__ __forceinline__ float epi_x16(float v) { return __int_as_float(__builtin_amdgcn_ds_swizzle(__float_as_int(v), (16 << 10) | 0x1F)); }
__device__ __forceinline__ float epi_x32sum(float v) { auto rr = __builtin_amdgcn_permlane32_swap(__float_as_uint(v), __float_as_uint(v), false, false); return __uint_as_float(rr[0]) + __uint_as_float(rr[1]); }
struct EpiStoreN {
    static constexpr bool PERM = true, AFTER_DRAIN = false, PERMA = false;
    bf16_t* O; int ldc; const float* SSP; int Mrows; const int* positions; int rope_mode; bf16_t* O2;
    __device__ __forceinline__ void operator()(const f32x4 (&acc)[2][2][4][2], const Unit& u, int wr, int wc, int fr, int fq) const {
        const int row0 = u.pm * BM + wr * 64 + fr, col0 = u.pn * BM + wc * 32 + 8 * fq;
        const bool rope1 = (rope_mode == 1) && (u.pn < 16);
        const bool nq = (rope_mode == 2) && (u.pn >= 12) && (u.pn < 16);
        const bool rope2t = (rope_mode == 2) && ((u.pn < 8) || nq || (u.pn == 18) || (u.pn == 20));
        const bool rope2 = rope2t && (wc == 0);
        const float ksc = (rope1 && u.pn >= 8) ? 0.0625f : 1.0f;
        float inv[2][4];
        if (rope1) {
#pragma unroll
            for (int n = 0; n < 2; ++n)
#pragma unroll
                for (int j = 0; j < 4; ++j) inv[n][j] = exp2f(-(float)(wc * 32 + 8 * fq + 4 * n + j) * (13.287712379549449f / 128.0f)) * 0.15915494309189535f;
        } else if (rope2) {
#pragma unroll
            for (int n = 0; n < 2; ++n)
#pragma unroll
                for (int j = 0; j < 4; ++j) inv[n][j] = exp2f(-(float)(8 * (fq & 1) + 4 * n + j) * (18.931568569324174f / 16.0f)) * 0.15915494309189535f;
        }
        float spa[2][4], spb[2][4]; int posi[2][4];
        const int* pp = (rope1 || rope2) ? positions : (const int*)SSP;
#pragma unroll
        for (int ai = 0; ai < 2; ++ai)
#pragma unroll
            for (int m = 0; m < 4; ++m) { const int row = row0 + ai * HALF + m * 16;
                spa[ai][m] = SSP[(size_t)(2 * fq) * Mrows + row]; spb[ai][m] = SSP[(size_t)(2 * fq + 1) * Mrows + row];
                posi[ai][m] = pp[row]; }
        asm volatile("" ::: "memory");
        float sp[2][4], posf[2][4];
#pragma unroll
        for (int ai = 0; ai < 2; ++ai)
#pragma unroll
            for (int m = 0; m < 4; ++m) { sp[ai][m] = spa[ai][m] + spb[ai][m]; posf[ai][m] = (float)posi[ai][m]; }
#pragma unroll
        for (int ai = 0; ai < 2; ++ai)
#pragma unroll
            for (int m = 0; m < 4; ++m) { const int row = row0 + ai * HALF + m * 16;
                float s = sp[ai][m];
                s += epi_x16(s); s = epi_x32sum(s);
                const float rstd = __builtin_amdgcn_rsqf(s * (1.0f / 2048.0f) + 1e-6f) * ksc;
                f32x4 v[2][2];
#pragma unroll
                for (int bj = 0; bj < 2; ++bj)
#pragma unroll
                    for (int n = 0; n < 2; ++n) v[bj][n] = acc[ai][bj][m][n] * rstd;
                bf16_t* rowp = O + (size_t)row * ldc + col0;
                if (nq) {
#pragma unroll
                    for (int bj = 0; bj < 2; ++bj) { u32x4 w; w.x = cvt_pk_bf16(v[bj][0][0], v[bj][0][1]); w.y = cvt_pk_bf16(v[bj][0][2], v[bj][0][3]); w.z = cvt_pk_bf16(v[bj][1][0], v[bj][1][1]); w.w = cvt_pk_bf16(v[bj][1][2], v[bj][1][3]);
                        *(u32x4*)(rowp + bj * HALF) = w; }
                    rowp = O2 + (size_t)row * 1024 + (u.pn - 12) * BM + wc * 32 + 8 * fq;
                }
                if (rope1) { const float pos = posf[ai][m];
#pragma unroll
                    for (int n = 0; n < 2; ++n)
#pragma unroll
                        for (int j = 0; j < 4; ++j) { const float rev = __builtin_amdgcn_fractf(pos * inv[n][j]);
                            const float sn = __builtin_amdgcn_sinf(rev), cs = __builtin_amdgcn_cosf(rev);
                            const float x1 = v[0][n][j], x2 = v[1][n][j]; v[0][n][j] = x1 * cs - x2 * sn; v[1][n][j] = x1 * sn + x2 * cs; } }
                if (rope2) {
                    const float pos = posf[ai][m];
#pragma unroll
                    for (int bj = 0; bj < 2; ++bj)
#pragma unroll
                        for (int n = 0; n < 2; ++n)
#pragma unroll
                            for (int j = 0; j < 4; ++j) { const float x = v[bj][n][j];
                                auto rr = __builtin_amdgcn_permlane32_swap(__float_as_uint(x), __float_as_uint(x), false, false);
                                const float px = __uint_as_float(fq >= 2 ? rr[0] : rr[1]);
                                const float rev = __builtin_amdgcn_fractf(pos * inv[n][j]); const float sn = __builtin_amdgcn_sinf(rev), cs = __builtin_amdgcn_cosf(rev);
                                v[bj][n][j] = (fq < 2) ? (x * cs - px * sn) : (px * sn + x * cs); } }
#pragma unroll
                for (int bj = 0; bj < 2; ++bj) { u32x4 w; w.x = cvt_pk_bf16(v[bj][0][0], v[bj][0][1]); w.y = cvt_pk_bf16(v[bj][0][2], v[bj][0][3]); w.z = cvt_pk_bf16(v[bj][1][0], v[bj][1][1]); w.w = cvt_pk_bf16(v[bj][1][2], v[bj][1][3]);
                    *(u32x4*)(rowp + bj * HALF) = w; } }
    }
};
struct EpiResid3 {
    static constexpr bool PERM = true, AFTER_DRAIN = false, PERMA = false;
    bf16_t* HB; float* SSP; int Mrows; PG8_LAS float* scr; int ldc;
    __device__ __forceinline__ void operator()(const f32x4 (&acc)[2][2][4][2], const Unit& u, int wr, int wc, int fr, int fq) const {
        const int row0 = u.pm * BM + wr * 64 + fr, col0 = u.pn * BM + wc * 32 + 8 * fq;
        u32x4 old[2][4][2];
#pragma unroll
        for (int ai = 0; ai < 2; ++ai)
#pragma unroll
            for (int m = 0; m < 4; ++m)
#pragma unroll
                for (int bj = 0; bj < 2; ++bj) old[ai][m][bj] = *(const u32x4*)(HB + (size_t)(row0 + ai * HALF + m * 16) * ldc + col0 + bj * HALF);
#pragma unroll
        for (int ai = 0; ai < 2; ++ai)
#pragma unroll
            for (int m = 0; m < 4; ++m) { bf16_t* rowp = HB + (size_t)(row0 + ai * HALF + m * 16) * ldc + col0; float ss = 0.f;
#pragma unroll
                for (int bj = 0; bj < 2; ++bj) { const u32x4 o4 = old[ai][m][bj];
                    const f32x4 a0 = acc[ai][bj][m][0], a1 = acc[ai][bj][m][1];
                    const float h0 = __uint_as_float(o4.x << 16) + a0[0], h1 = __uint_as_float(o4.x & 0xffff0000u) + a0[1], h2 = __uint_as_float(o4.y << 16) + a0[2], h3 = __uint_as_float(o4.y & 0xffff0000u) + a0[3];
                    const float h4 = __uint_as_float(o4.z << 16) + a1[0], h5 = __uint_as_float(o4.z & 0xffff0000u) + a1[1], h6 = __uint_as_float(o4.w << 16) + a1[2], h7 = __uint_as_float(o4.w & 0xffff0000u) + a1[3];
                    u32x4 w; w.x = cvt_pk_bf16(h0, h1); w.y = cvt_pk_bf16(h2, h3); w.z = cvt_pk_bf16(h4, h5); w.w = cvt_pk_bf16(h6, h7);
                    *(u32x4*)(rowp + bj * HALF) = w;
                    ss += ((h0 * h0 + h1 * h1) + (h2 * h2 + h3 * h3)) + ((h4 * h4 + h5 * h5) + (h6 * h6 + h7 * h7)); }
                ss += epi_x16(ss); ss = epi_x32sum(ss);
                if (fq == 0) scr[(ai * HALF + wr * 64 + m * 16 + fr) * 4 + wc] = ss; }
        asm volatile("s_waitcnt lgkmcnt(0)" ::: "memory"); __builtin_amdgcn_s_barrier(); asm volatile("" ::: "memory");
        const int t = (wr * 4 + wc) * 64 + fq * 16 + fr;
        if (t < 256) { const f32x4 p = *(const PG8_LAS f32x4*)(scr + t * 4); SSP[(size_t)u.pn * Mrows + u.pm * BM + t] = (p[0] + p[1]) + (p[2] + p[3]); }
    }
};

#define DPPF(old, src, CTRL) __int_as_float(__builtin_amdgcn_update_dpp(__float_as_int(old), __float_as_int(src), (CTRL), 0xf, 0xf, false))
#define DPPR(src, CTRL) __int_as_float(__builtin_amdgcn_mov_dpp(__float_as_int(src), (CTRL), 0xf, 0xf, true))
struct EpiStoreFFN {
    static constexpr bool PERM = true, AFTER_DRAIN = false, PERMA = true;
    bf16_t* ACT; const float* SSP; int Mrows; const float* cw  ; const float* cb  ; bf16_t* UH  ; PG8_LAS float* scr  ;
    __device__ __forceinline__ void operator()(const f32x4 (&acc)[2][2][4][2], const Unit& u, int wr, int wc, int fr_in, int fq_in) const {
        constexpr int DFFc = 5632, DFF2c = 11264;
        int z_ = 0; asm volatile("" : "+v"(z_)); const int lane_ = (int)__builtin_amdgcn_mbcnt_hi(~0u, __builtin_amdgcn_mbcnt_lo(~0u, (unsigned)z_));
        const int fr = lane_ & 15, fq = lane_ >> 4; (void)fr_in; (void)fq_in;
        const int row0 = u.pm * BM + wr * 64 + 4 * fr;
        const int g0 = u.pn * 128 + wc * 32 + 8 * fq;
        PG8_LAS float* RT = scr + 2048;
        const int t = (wr * 4 + wc) * 64 + fq * 16 + fr;
        float sp_[8], cw0 = 0.f, cw1 = 0.f, cw2 = 0.f, cb0 = 0.f;
        if (t < 256) { const size_t row = (size_t)u.pm * BM + t;
#pragma unroll
            for (int j = 0; j < 8; ++j) sp_[j] = SSP[(size_t)j * Mrows + row];
            const int gc = (t < 128) ? (u.pn * 128 + t) : (DFFc + u.pn * 128 + (t - 128));
            cw0 = cw[gc]; cw1 = cw[DFF2c + gc]; cw2 = cw[2 * DFF2c + gc]; cb0 = cb[gc]; }
        const int wslot = (wr * 4 + wc) * 2;
        typedef unsigned u32x2e __attribute__((ext_vector_type(2)));
        if (fr == 15) {
#pragma unroll
            for (int ai = 0; ai < 2; ++ai)
#pragma unroll
                for (int bj = 0; bj < 2; ++bj)
#pragma unroll
                    for (int n = 0; n < 2; ++n)
#pragma unroll
                        for (int mm = 2; mm < 4; ++mm) *(PG8_LAS f32x4*)(scr + (((wslot + ai) * 2 + (mm - 2)) * 64 + bj * 32 + 8 * fq + 4 * n)) = acc[ai][bj][mm][n];
        }
        if (t < 256) { float s_ = 0.f;
#pragma unroll
            for (int j = 0; j < 8; ++j) s_ += sp_[j];
            RT[t] = __builtin_amdgcn_rsqf(s_ * (1.0f / 2048.0f) + 1e-6f);
            scr[2304 + t] = cw0; scr[2304 + 256 + t] = cw1; scr[2304 + 512 + t] = cw2; scr[2304 + 768 + t] = cb0;
            scr[3328 + t] = 0.f; scr[3328 + 256 + t] = 0.f; }
        asm volatile("s_waitcnt lgkmcnt(0)" ::: "memory"); __builtin_amdgcn_s_barrier(); asm volatile("" ::: "memory");
        auto rstd4 = [&](int ai) { return *(const PG8_LAS f32x4*)(RT + ai * HALF + wr * 64 + 4 * fr); };
        if (wr == 1 && fr == 15) { const f32x4 rs4 = rstd4(1);
#pragma unroll
            for (int bj = 0; bj < 2; ++bj)
#pragma unroll
                for (int n = 0; n < 2; ++n)
#pragma unroll
                    for (int mm = 2; mm < 4; ++mm) { const f32x4 x = acc[1][bj][mm][n] * rs4[mm]; bf16_t* p = UH + ((size_t)u.pm * 4 + mm) * DFF2c + bj * DFFc + g0 + 4 * n;
                        u32x2e w; w.x = cvt_pk_bf16(x[0], x[1]); w.y = cvt_pk_bf16(x[2], x[3]); *(u32x2e*)p = w; }
        }
        if (wr == 0 && fr == 0) { const f32x4 rs4 = rstd4(0);
#pragma unroll
            for (int bj = 0; bj < 2; ++bj)
#pragma unroll
                for (int n = 0; n < 2; ++n)
#pragma unroll
                    for (int mm = 0; mm < 2; ++mm) { const f32x4 x = acc[0][bj][mm][n] * rs4[mm]; bf16_t* p = UH + ((size_t)u.pm * 4 + mm) * DFF2c + bj * DFFc + g0 + 4 * n;
                        u32x2e w; w.x = cvt_pk_bf16(x[0], x[1]); w.y = cvt_pk_bf16(x[2], x[3]); *(u32x2e*)p = w; }
        }
#pragma unroll
        for (int n = 0; n < 2; ++n) {
            f32x4 wg[3], wv[3], bg, bv;
            { const PG8_LAS float* WT = scr + 2304 + wc * 32 + 8 * fq + 4 * n;
#pragma unroll
              for (int i = 0; i < 3; ++i) { wg[i] = *(const PG8_LAS f32x4*)(WT + i * 256); wv[i] = *(const PG8_LAS f32x4*)(WT + i * 256 + 128); }
              bg = *(const PG8_LAS f32x4*)(WT + 768); bv = *(const PG8_LAS f32x4*)(WT + 768 + 128); }
#pragma unroll
            for (int ai = 0; ai < 2; ++ai) {
                const bool have = !(wr == 0 && ai == 0);
                const int src = (wr == 1) ? ((0 * 4 + wc) * 2 + ai) : ((1 * 4 + wc) * 2 + 0);
                const int hb = (have ? src * 128 : 3328 + wc * 128) + 8 * fq + 4 * n, rb = have ? ai * HALF + wr * 64 - 2 : 0;
                const float r14 = RT[rb], r15 = RT[rb + 1];
                const f32x4 hg14 = *(const PG8_LAS f32x4*)(scr + hb) * r14, hg15 = *(const PG8_LAS f32x4*)(scr + hb + 64) * r15;
                const f32x4 hv14 = *(const PG8_LAS f32x4*)(scr + hb + 32) * r14, hv15 = *(const PG8_LAS f32x4*)(scr + hb + 64 + 32) * r15;
                const f32x4 rs4 = rstd4(ai);
                f32x4 xg[4], xv[4];
#pragma unroll
                for (int m = 0; m < 4; ++m) { xg[m] = acc[ai][0][m][n] * rs4[m]; xv[m] = acc[ai][1][m][n] * rs4[m]; }
                f32x4 g1, g2, v1, v2;
#pragma unroll
                for (int j = 0; j < 4; ++j) { g1[j] = DPPF(hg15[j], xg[3][j], 0x111); g2[j] = DPPF(hg14[j], xg[2][j], 0x111); v1[j] = DPPF(hv15[j], xv[3][j], 0x111); v2[j] = DPPF(hv14[j], xv[2][j], 0x111); }
#pragma unroll
                for (int m = 0; m < 4; ++m) {
                    const f32x4 pg1 = (m == 0) ? g1 : xg[m - 1], pg2 = (m == 0) ? g2 : ((m == 1) ? g1 : xg[m - 2]);
                    const f32x4 pv1 = (m == 0) ? v1 : xv[m - 1], pv2 = (m == 0) ? v2 : ((m == 1) ? v1 : xv[m - 2]);
                    const f32x4 cg = bg + wg[2] * xg[m] + wg[1] * pg1 + wg[0] * pg2, cv = bv + wv[2] * xv[m] + wv[1] * pv1 + wv[0] * pv2;
                    f32x4 a;
#pragma unroll
                    for (int j = 0; j < 4; ++j) a[j] = cg[j] * __builtin_amdgcn_rcpf(1.0f + __builtin_amdgcn_exp2f(-1.4426950408889634f * cg[j])) * cv[j];
                    { u32x2e w; w.x = cvt_pk_bf16(a[0], a[1]); w.y = cvt_pk_bf16(a[2], a[3]);
                      *(u32x2e*)(ACT + (size_t)(row0 + ai * HALF + m) * DFFc + g0 + 4 * n) = w; }
                }
            }
        }
    }
};

template <class Epi, class Sched, bool ALIGN_EPI = false, bool SP2 = false>
__device__ __forceinline__ void gemm_phase(PG8_LAS unsigned char* lds, const Gemm g, const Sched& S, const Epi& E, int tid_in) {
    int tid_raw = tid_in; asm volatile("" : "+v"(tid_raw));
    const int tid = tid_raw, wid = __builtin_amdgcn_readfirstlane(tid >> 6), lane = tid & 63, wr = wid >> 2, wc = (wid + (wid >> 2)) & 3, fr = lane & 15, fq = lane >> 4;
    const int K = g.K, nt = K / BK;
    unsigned voffA[2], voffB[2];
#pragma unroll
    for (int i = 0; i < 2; ++i) { int R, C; stage_rc(tid * 16 + i * 8192, R, C); const int Rb = Epi::PERM ? ((R & ~31) + perm32(R & 31)) : R;
        if (Epi::PERMA) R = (R & ~63) + 4 * (R & 15) + ((R >> 4) & 3);
        voffA[i] = (unsigned)(R * K + C) * 2u; voffB[i] = (unsigned)(Rb * K + C) * 2u; }
    const size_t kstep = (size_t)(BK * 2);
    const size_t hstep = (size_t)HALF * K * 2;
    const size_t tstep = 2 * hstep;
    const unsigned ldsw = (unsigned)wid * 1024u;
    const int aoff = lds_byte(wr * 64 + fr, fq * 8), boff = lds_byte(wc * 32 + fr, fq * 8);
#define PG8_SA(b, h) (((b) * 2 + (h)) * HTB)
#define PG8_SB(b, h) ((4 + (b) * 2 + (h)) * HTB)
#define PG8_STAGE(bufoff, gbase, voff) do { _Pragma("unroll") for (int _i = 0; _i < 2; ++_i) \
        __builtin_amdgcn_global_load_lds((const unsigned*)((const char*)(gbase) + (voff)[_i]), (PG8_LAS unsigned*)(lds + (bufoff) + ldsw + _i * 8192), 16, 0, 0); } while (0)
#define PG8_LDA(dst, b, h) do { _Pragma("unroll") for (int m = 0; m < 4; ++m) _Pragma("unroll") for (int k = 0; k < 2; ++k) dst[m][k] = *(const PG8_LAS bf16x8*)(lds + PG8_SA(b, h) + aoff + m * 2048 + k * 1024); } while (0)
#define PG8_LDB(dst, b, h) do { _Pragma("unroll") for (int n = 0; n < 2; ++n) _Pragma("unroll") for (int k = 0; k < 2; ++k) dst[n][k] = *(const PG8_LAS bf16x8*)(lds + PG8_SB(b, h) + boff + n * 2048 + k * 1024); } while (0)
#define PG8_MMA(ai, bj, At, Bt) do { __builtin_amdgcn_s_setprio(1); _Pragma("unroll") for (int m = 0; m < 4; ++m) _Pragma("unroll") for (int n = 0; n < 2; ++n) _Pragma("unroll") for (int k = 0; k < 2; ++k) \
        acc[ai][bj][m][n] = __builtin_amdgcn_mfma_f32_16x16x32_bf16(Bt[n][k], At[m][k], acc[ai][bj][m][n], 0, 0, 0); __builtin_amdgcn_s_setprio(0); } while (0)
#define PG8_WAIT_V(n) asm volatile("s_waitcnt vmcnt(" #n ")" ::: "memory")
#define PG8_WAIT_L(n) asm volatile("s_waitcnt lgkmcnt(" #n ")" ::: "memory")
#define PG8_BAR __builtin_amdgcn_s_barrier()
#define PG8_SCHED __builtin_amdgcn_sched_barrier(0)
    Unit cur, nxt; int ui = 0;
    if (!S.next(0, cur)) return;
    f32x4 acc[2][2][4][2];
#pragma unroll
    for (int a = 0; a < 2; ++a)
#pragma unroll
        for (int b = 0; b < 2; ++b)
#pragma unroll
            for (int m = 0; m < 4; ++m)
#pragma unroll
                for (int n = 0; n < 2; ++n) acc[a][b][m][n] = (f32x4){0.f, 0.f, 0.f, 0.f};
    bf16x8 At[4][2], B0[2][2], B1[2][2];
    const char* cA = (const char*)g.A + (size_t)cur.pm * tstep; const char* cB = (const char*)g.Bt + (size_t)cur.pn * tstep;
    S.a_ready(cur);
    if constexpr (SP2) {
        PG8_STAGE(PG8_SB(0, 0), cB, voffB); PG8_STAGE(PG8_SB(0, 1), cB + hstep, voffB); PG8_STAGE(PG8_SA(0, 0), cA, voffA); PG8_STAGE(PG8_SA(0, 1), cA + hstep, voffA);
        if (wr == 1) PG8_BAR;
        PG8_WAIT_V(2); PG8_BAR;
        PG8_STAGE(PG8_SB(1, 0), cB + kstep, voffB); PG8_STAGE(PG8_SA(1, 0), cA + kstep, voffA); PG8_STAGE(PG8_SB(1, 1), cB + hstep + kstep, voffB);
        PG8_WAIT_V(6); PG8_BAR;
    } else {
        PG8_STAGE(PG8_SB(0, 0), cB, voffB); PG8_STAGE(PG8_SA(0, 0), cA, voffA); PG8_STAGE(PG8_SB(0, 1), cB + hstep, voffB); PG8_STAGE(PG8_SA(0, 1), cA + hstep, voffA);
        if (wr == 1) PG8_BAR;
        PG8_WAIT_V(4); PG8_BAR;
        PG8_STAGE(PG8_SB(1, 0), cB + kstep, voffB); PG8_STAGE(PG8_SA(1, 0), cA + kstep, voffA); PG8_STAGE(PG8_SB(1, 1), cB + hstep + kstep, voffB);
        PG8_WAIT_V(6); PG8_BAR;
    }
    for (;;) {
        const bool has_next = S.next(ui + 1, nxt);
        const char* nA = has_next ? (const char*)g.A + (size_t)nxt.pm * tstep : cA; const char* nB = has_next ? (const char*)g.Bt + (size_t)nxt.pn * tstep : cB;
        for (int t = 0; t < nt; t += 2) {
            const bool last = (t == nt - 2);
            const char* a1 = cA + (size_t)(t + 1) * kstep;
            const char* a2 = last ? nA : cA + (size_t)(t + 2) * kstep; const char* b2 = last ? nB : cB + (size_t)(t + 2) * kstep;
            const char* a3 = a2 + kstep; const char* b3 = b2 + kstep;
            if (last && has_next) S.a_ready(nxt);
            if constexpr (SP2) {
            PG8_LDB(B0, 0, 0); PG8_LDB(B1, 0, 1); PG8_SCHED; PG8_LDA(At, 0, 0); PG8_STAGE(PG8_SA(1, 1), a1 + hstep, voffA);
            PG8_WAIT_V(8); PG8_WAIT_L(0); PG8_BAR; PG8_MMA(0, 0, At, B0); PG8_MMA(0, 1, At, B1); PG8_BAR; PG8_SCHED;
            PG8_LDA(At, 0, 1); PG8_STAGE(PG8_SB(0, 0), b2, voffB); PG8_STAGE(PG8_SB(0, 1), b2 + hstep, voffB); PG8_STAGE(PG8_SA(0, 0), a2, voffA);
            PG8_WAIT_V(8); PG8_WAIT_L(0); PG8_BAR; PG8_MMA(1, 0, At, B0); PG8_MMA(1, 1, At, B1); PG8_BAR; PG8_SCHED;
            PG8_LDB(B0, 1, 0); PG8_LDB(B1, 1, 1); PG8_SCHED; PG8_LDA(At, 1, 0); PG8_STAGE(PG8_SA(0, 1), a2 + hstep, voffA);
            PG8_WAIT_V(8); PG8_WAIT_L(0); PG8_BAR; PG8_MMA(0, 0, At, B0); PG8_MMA(0, 1, At, B1); PG8_BAR; PG8_SCHED;
            PG8_LDA(At, 1, 1); PG8_STAGE(PG8_SB(1, 0), b3, voffB); PG8_STAGE(PG8_SB(1, 1), b3 + hstep, voffB); PG8_STAGE(PG8_SA(1, 0), a3, voffA);
            PG8_WAIT_V(8); PG8_WAIT_L(0); PG8_BAR; PG8_MMA(1, 0, At, B0); PG8_MMA(1, 1, At, B1); PG8_BAR; PG8_SCHED;
            } else {
            PG8_LDB(B0, 0, 0); PG8_SCHED; PG8_LDA(At, 0, 0); PG8_STAGE(PG8_SA(1, 1), a1 + hstep, voffA);
            PG8_WAIT_L(8); PG8_BAR; PG8_WAIT_L(0); PG8_MMA(0, 0, At, B0); PG8_BAR; PG8_SCHED;
            PG8_LDB(B1, 0, 1); PG8_STAGE(PG8_SB(0, 0), b2, voffB);
            PG8_BAR; PG8_WAIT_L(0); PG8_MMA(0, 1, At, B1); PG8_BAR;
            PG8_LDA(At, 0, 1); PG8_STAGE(PG8_SA(0, 0), a2, voffA);
            PG8_BAR; PG8_WAIT_L(0); PG8_MMA(1, 0, At, B0); PG8_BAR; PG8_SCHED;
            PG8_STAGE(PG8_SB(0, 1), b2 + hstep, voffB);
            PG8_WAIT_V(6); PG8_BAR; PG8_MMA(1, 1, At, B1); PG8_BAR;
            PG8_LDB(B0, 1, 0); PG8_SCHED; PG8_LDA(At, 1, 0); PG8_STAGE(PG8_SA(0, 1), a2 + hstep, voffA);
            PG8_WAIT_L(8); PG8_BAR; PG8_WAIT_L(0); PG8_MMA(0, 0, At, B0); PG8_BAR; PG8_SCHED;
            PG8_LDB(B1, 1, 1); PG8_STAGE(PG8_SB(1, 0), b3, voffB);
            PG8_BAR; PG8_WAIT_L(0); PG8_MMA(0, 1, At, B1); PG8_BAR;
            PG8_LDA(At, 1, 1); PG8_STAGE(PG8_SA(1, 0), a3, voffA);
            PG8_BAR; PG8_WAIT_L(0); PG8_MMA(1, 0, At, B0); PG8_BAR; PG8_SCHED;
            PG8_STAGE(PG8_SB(1, 1), b3 + hstep, voffB);
            PG8_WAIT_V(6); PG8_BAR; PG8_MMA(1, 1, At, B1); PG8_BAR;
            }
        }
        if constexpr (ALIGN_EPI) { if (wr == 0) PG8_BAR; }
        if constexpr (!Epi::AFTER_DRAIN) { E(acc, cur, wr, wc, fr, fq); S.done(cur); }
        if (!has_next) break;
#pragma unroll
        for (int a = 0; a < 2; ++a)
#pragma unroll
            for (int b = 0; b < 2; ++b)
#pragma unroll
                for (int m = 0; m < 4; ++m)
#pragma unroll
                    for (int n = 0; n < 2; ++n) acc[a][b][m][n] = (f32x4){0.f, 0.f, 0.f, 0.f};
        cur = nxt; cA = nA; cB = nB; ++ui;
        if constexpr (ALIGN_EPI) { if (wr == 1) PG8_BAR; }
    }
    PG8_WAIT_V(0);
    if constexpr (!ALIGN_EPI) { if (wr == 0) PG8_BAR; }
    PG8_BAR;
    if constexpr (Epi::AFTER_DRAIN) { E.fused(acc, cur, wr, wc, fr, fq, lds, wid, lane); S.done(cur); }
#undef PG8_SA
#undef PG8_SB
#undef PG8_STAGE
#undef PG8_LDA
#undef PG8_LDB
#undef PG8_MMA
#undef PG8_WAIT_V
#undef PG8_WAIT_L
#undef PG8_BAR
#undef PG8_SCHED
}
}
#define XB_TMO      128
#define XB_XCNT(j)  (256  + 64 * (j))
#define XB_XSUB(j)  (1280 + 64 * (j))
#define XB_XGEN(j)  (2304 + 64 * (j))
#define XB_TOP      3328
#define XB_TOPGEN   3392
#define XCD_BAR_WORDS 3456
#define XB_SPIN_CAP (1u << 18)
#define LAS __attribute__((address_space(3)))

__device__ __forceinline__ unsigned xb_ld(unsigned* p)              { return __hip_atomic_load(p, __ATOMIC_RELAXED, __HIP_MEMORY_SCOPE_AGENT); }
__device__ __forceinline__ unsigned xb_add(unsigned* p, unsigned v) { return __hip_atomic_fetch_add(p, v, __ATOMIC_RELAXED, __HIP_MEMORY_SCOPE_AGENT); }
__device__ __forceinline__ unsigned xb_xcc_id() { return (unsigned)__builtin_amdgcn_s_getreg((3 << 11) | 20) & 0xFu; }
#define XB_SPIN(cond, bar) do { unsigned _sp = 0; while (cond) { __builtin_amdgcn_s_sleep(1); \
    if ((++_sp & 255u) == 0u) { if (xb_ld(&(bar)[XB_TMO])) break; if (_sp > XB_SPIN_CAP) { atomicAdd(&(bar)[XB_TMO], 1u); break; } } } } while (0)

struct XcdBarrier {
    unsigned* bar; unsigned x;
    volatile LAS unsigned* st;
    int lead;
};

__device__ __forceinline__ XcdBarrier xcd_barrier_post(unsigned* bar, volatile LAS unsigned* st) {
    XcdBarrier b; b.bar = bar; b.x = xb_xcc_id(); b.st = st; b.lead = (threadIdx.x == 0);
    if (threadIdx.x == 0) (void)xb_add(&bar[XB_XCNT(b.x)], 1u);
    return b;
}
__device__ __forceinline__ void xcd_barrier_complete(unsigned* bar, unsigned x, unsigned& nloc, unsigned& nx) {
    const unsigned G = gridDim.x * gridDim.y * gridDim.z;
    unsigned sum, cnt, mine, sp = 0u;
    for (;;) {
        sum = 0u; cnt = 0u; mine = 0u;
#pragma unroll
        for (unsigned j = 0; j < 16; ++j) { const unsigned c = xb_ld(&bar[XB_XCNT(j)]); sum += c; cnt += (c > 0u) ? 1u : 0u; mine = (j == x) ? c : mine; }
        if (sum == G) break;
        __builtin_amdgcn_s_sleep(1);
        if ((++sp & 255u) == 0u) { if (xb_ld(&bar[XB_TMO])) break; if (sp > XB_SPIN_CAP) { atomicAdd(&bar[XB_TMO], 1u); break; } }
    }
    nloc = mine > 0u ? mine : 1u; nx = cnt > 0u ? cnt : 1u;
}

__device__ __forceinline__ void xcd_barrier(const XcdBarrier& b) {
    asm volatile("s_waitcnt vmcnt(0)" ::: "memory");
    __syncthreads();
    if (b.lead) {
        unsigned* bar = b.bar;
        __builtin_amdgcn_s_waitcnt(0);
        unsigned nloc = b.st[0], nx = b.st[1];
        if (nloc == 0u) { xcd_barrier_complete(bar, b.x, nloc, nx); b.st[0] = nloc; b.st[1] = nx; }
        const unsigned old = xb_add(&bar[XB_XSUB(b.x)], 1u);
        const unsigned gen = old / nloc;
        if (old + 1u == (gen + 1u) * nloc) {
            __builtin_amdgcn_fence(__ATOMIC_RELEASE, "agent");
            asm volatile("s_waitcnt vmcnt(0)" ::: "memory");
            const unsigned og = xb_add(&bar[XB_TOP], 1u);
            const unsigned tg = og / nx;
            if (og + 1u == (tg + 1u) * nx) xb_add(&bar[XB_TOPGEN], 1u);
            else XB_SPIN(xb_ld(&bar[XB_TOPGEN]) == tg, bar);
            __builtin_amdgcn_fence(__ATOMIC_ACQUIRE, "agent");
            xb_add(&bar[XB_XGEN(b.x)], 1u);
            asm volatile("s_waitcnt vmcnt(0)" ::: "memory");
        } else {
            XB_SPIN(xb_ld(&bar[XB_XGEN(b.x)]) == gen, bar);
            __builtin_amdgcn_fence(__ATOMIC_ACQUIRE, "agent");
            asm volatile("s_waitcnt vmcnt(0)" ::: "memory");
        }
    }
    __syncthreads();
}

#define GAS __attribute__((address_space(1)))
using pg8::bf16_t; using pg8::bf16x8; using pg8::f32x4; using pg8::u32x4;
typedef short s16x4 __attribute__((ext_vector_type(4)));
typedef float f32x16 __attribute__((ext_vector_type(16)));
typedef unsigned u32x2 __attribute__((ext_vector_type(2)));

constexpr int D = 2048, BATCH = 4, SEQ = 4096, M = BATCH * SEQ, DEPTH = 4;
constexpr int AB_PAD = 5888, AB_COLS = 5656, C_COLS = 12288, DFF = 5632, DFF2 = 11264;
constexpr int NWAVES = 8, NTHREADS = 512;
constexpr float RMS_EPS = 1e-6f;

constexpr size_t MiB = (size_t)1 << 20;
constexpr size_t WS_CTL = 0, CTL_ZERO_BYTES = 1 * MiB;
constexpr size_t WS_KMEAN = 2 * MiB;
constexpr size_t WS_KC = 3 * MiB, WS_VC = 4 * MiB;
constexpr size_t WS_W1K = 5 * MiB, WS_W1V = 7 * MiB;
constexpr size_t WS_W2K = 9 * MiB, WS_W2V = 9 * MiB + 256 * 1024;
constexpr size_t WS_SSP = 10 * MiB;
constexpr size_t WS_MEMN = 16 * MiB;
constexpr size_t WS_MEMKV = 20 * MiB;
constexpr size_t WS_QX = 28 * MiB, WS_AX = 44 * MiB;
constexpr size_t WS_NQROT = 60 * MiB;
constexpr size_t WS_H = 96 * MiB;
constexpr size_t WS_HN = 224 * MiB;
constexpr size_t WS_R1 = 288 * MiB;
constexpr size_t WS_ACT = WS_R1 + 352 * MiB;
constexpr size_t WS_Y = WS_R1 + 384 * MiB;
constexpr size_t WS_WINAB = 816 * MiB;
constexpr size_t WS_WOUTAB = 862 * MiB;
constexpr size_t WS_WINC = 878 * MiB;
constexpr size_t WS_WOUTC = 974 * MiB;
constexpr size_t WS_WQX = 1006 * MiB;
constexpr size_t WS_WKVALL = 1014 * MiB;
constexpr size_t WS_WOX = 1030 * MiB;
constexpr size_t WS_WUP = 1038 * MiB;
constexpr size_t WS_WDOWN = 1214 * MiB;
constexpr size_t WS_ATT = 1302 * MiB;
constexpr size_t WS_END = 1366 * MiB;
constexpr int CW_BAR = 4096;
constexpr int CW_QUEUE = 16384;

constexpr int RING_BYTES = 147456;
constexpr int MISC_OFF = 147456;
constexpr int KMEAN_OFF = MISC_OFF + 1024;
constexpr int SELM_OFF = KMEAN_OFF + 8192;
constexpr int LDS_BYTES = 163840;

constexpr int PH_G0 = 0, PH_L0 = 1, PH_PER_LAYER = 10, PH_FINAL = 41, N_PHASES = 42;
constexpr int EPI_SCR_OFF = 131072;

#define MFMA32(a, b, c) __builtin_amdgcn_mfma_f32_32x32x16_bf16((a), (b), (c), 0, 0, 0)
typedef __bf16 bf16x2_t __attribute__((ext_vector_type(2)));
typedef float f32x2_t __attribute__((ext_vector_type(2)));
__device__ __forceinline__ unsigned cvtpk(float lo, float hi) { const f32x2_t f = {lo, hi}; const bf16x2_t v = __builtin_convertvector(f, bf16x2_t); return __builtin_bit_cast(unsigned, v); }
__device__ __forceinline__ float bflo(unsigned w) { return __uint_as_float(w << 16); }
__device__ __forceinline__ float bfhi(unsigned w) { return __uint_as_float(w & 0xffff0000u); }
__device__ __forceinline__ float bf2f(bf16_t v) { return __uint_as_float(((unsigned)v) << 16); }
__device__ __forceinline__ bf16_t f2bf(float f) { return (bf16_t)(cvtpk(f, f) & 0xffffu); }
__device__ __forceinline__ int crow(int r, int hi) { return (r & 3) + 8 * (r >> 2) + 4 * hi; }
__device__ __forceinline__ unsigned offb(unsigned row, unsigned ch) { return 256u * row + 16u * (ch ^ (((row & 3u) << 2) | ((row >> 2) & 3u))); }
__device__ __forceinline__ unsigned offv(unsigned row, unsigned ch) { return 128u * row + 16u * (ch ^ (((row >> 1) & 1u) << 2)); }
__device__ __forceinline__ float xhalf_max(float v) { auto rr = __builtin_amdgcn_permlane32_swap(__float_as_uint(v), __float_as_uint(v), false, false); return fmaxf(__uint_as_float(rr[0]), __uint_as_float(rr[1])); }
__device__ __forceinline__ float xhalf_sum(float v) { auto rr = __builtin_amdgcn_permlane32_swap(__float_as_uint(v), __float_as_uint(v), false, false); return __uint_as_float(rr[0]) + __uint_as_float(rr[1]); }
__device__ __forceinline__ float xhalf_get(float v, int hi) { auto rr = __builtin_amdgcn_permlane32_swap(__float_as_uint(v), __float_as_uint(v), false, false); return __uint_as_float(hi ? rr[0] : rr[1]); }
template <int MASK> __device__ __forceinline__ float shx(float v) { static_assert(MASK < 32, "shx: inside 32-lane groups"); return __int_as_float(__builtin_amdgcn_ds_swizzle(__float_as_int(v), (MASK << 10) | 0x1F)); }
template <int MASK> __device__ __forceinline__ unsigned shxu(unsigned v) { return (unsigned)__builtin_amdgcn_ds_swizzle((int)v, (MASK << 10) | 0x1F); }
__device__ __forceinline__ float wave_sum(float v) {
    v += shx<1>(v); v += shx<2>(v); v += shx<4>(v); v += shx<8>(v); v += shx<16>(v);
    return xhalf_sum(v);
}
__device__ __forceinline__ float fast_exp2(float x) { return __builtin_amdgcn_exp2f(x); }
__device__ __forceinline__ float silu_f(float x) { return x * __builtin_amdgcn_rcpf(1.0f + fast_exp2(-1.4426950408889634f * x)); }
__device__ __forceinline__ float sigmoid_f(float x) { return __builtin_amdgcn_rcpf(1.0f + fast_exp2(-1.4426950408889634f * x)); }
__device__ __forceinline__ void sincos_rad(float ang, float& sn, float& cs) {
    float rev = ang * 0.15915494309189535f; rev = rev - floorf(rev);
    sn = __builtin_amdgcn_sinf(rev); cs = __builtin_amdgcn_cosf(rev);
}
template <int OFF> __device__ __forceinline__ s16x4 tr_read(unsigned addr) { return __builtin_amdgcn_ds_read_tr16_b64_v4i16((LAS s16x4*)(uintptr_t)(addr + (unsigned)OFF)); }
__device__ __forceinline__ s16x4 tr_read0(unsigned addr) { return __builtin_amdgcn_ds_read_tr16_b64_v4i16((LAS s16x4*)(uintptr_t)addr); }
#define LGKM_WAIT0() do { } while (0)
#define PK8(L, H) (bf16x8){L[0], L[1], L[2], L[3], H[0], H[1], H[2], H[3]}
__device__ __forceinline__ bf16x8 pack8(float a0, float a1, float a2, float a3, float a4, float a5, float a6, float a7) {
    u32x4 w; w.x = cvtpk(a0, a1); w.y = cvtpk(a2, a3); w.z = cvtpk(a4, a5); w.w = cvtpk(a6, a7); return __builtin_bit_cast(bf16x8, w);
}
__device__ __forceinline__ void unpack8(u32x4 w, float (&x)[8]) {
    x[0] = bflo(w.x); x[1] = bfhi(w.x); x[2] = bflo(w.y); x[3] = bfhi(w.y); x[4] = bflo(w.z); x[5] = bfhi(w.z); x[6] = bflo(w.w); x[7] = bfhi(w.w);
}
__device__ __forceinline__ u32x4 packu8(const float (&x)[8]) { u32x4 w; w.x = cvtpk(x[0], x[1]); w.y = cvtpk(x[2], x[3]); w.z = cvtpk(x[4], x[5]); w.w = cvtpk(x[6], x[7]); return w; }

__device__ __forceinline__ void transpose_item(const float* W, const float* gain  , int K, int N, bf16_t* WT, LAS float* scr, int item, int nblk, int lane, bool ffn_perm = false, bool frag = false) {
    const int kb = item / nblk, nb = item - kb * nblk, k0 = 64 * kb, n0 = 64 * nb;
    const int cl = 4 * (lane & 15), nn = n0 + cl; const bool ok = nn < N;
    const float* src = W + (size_t)(k0 + (lane >> 4)) * N + nn;
    f32x4 vv[16];
#pragma unroll
    for (int i = 0; i < 16; ++i) vv[i] = ok ? *(const f32x4*)(src + (size_t)(4 * i) * N) : (f32x4){0.f, 0.f, 0.f, 0.f};
#pragma unroll
    for (int i = 0; i < 16; ++i) { f32x4 v = vv[i];
        if (gain) v = v * gain[k0 + 4 * i + (lane >> 4)];
        LAS float* d = scr + (4 * i + (lane >> 4)) * 65 + cl; d[0] = v.x; d[1] = v.y; d[2] = v.z; d[3] = v.w; }
    asm volatile("s_waitcnt lgkmcnt(0)" ::: "memory");
    const int c = lane & 7;
#pragma unroll
    for (int j = 0; j < 8; ++j) { const int n = (lane >> 3) + 8 * j; const LAS float* s = scr + (8 * c) * 65 + n;
        u32x4 o; o.x = cvtpk(s[0 * 65], s[1 * 65]); o.y = cvtpk(s[2 * 65], s[3 * 65]); o.z = cvtpk(s[4 * 65], s[5 * 65]); o.w = cvtpk(s[6 * 65], s[7 * 65]);
        const int nsrc = n0 + n; const int nd = !ffn_perm ? nsrc : (nsrc < 5632 ? 256 * (nsrc >> 7) + (nsrc & 127) : 256 * ((nsrc - 5632) >> 7) + 128 + ((nsrc - 5632) & 127));
        if (frag) { const int kk = k0 + 8 * c; *(u32x4*)(WT + ((size_t)((((nd >> 5) * 32 + (kk >> 7)) * 8 + ((kk & 127) >> 4)) * 64 + ((kk >> 3) & 1) * 32 + (nd & 31))) * 8) = o; }
        else *(u32x4*)(WT + (size_t)nd * K + k0 + 8 * c) = o; }
    asm volatile("s_waitcnt lgkmcnt(0)" ::: "memory");
}
__device__ __forceinline__ void transpose_matrix(const float* W, const float* gain, int K, int N, int Npad, bf16_t* WT, LAS float* scr, int gw, int ngw, int lane, int& base, bool ffn_perm = false, bool frag = false) {
    const int nblk = Npad / 64, nitems = (K / 64) * nblk;
    int start = (gw - base) % ngw; if (start < 0) start += ngw;
    for (int it = start; it < nitems; it += ngw) transpose_item(W, gain, K, N, WT, scr, it, nblk, lane, ffn_perm, frag);
    base = (base + nitems) % ngw;
}
__device__ __forceinline__ void rms_row_bf16(const float* xrow, const float* gain, bf16_t* orow, int lane) {
    const f32x4* xr = (const f32x4*)xrow + lane; const f32x4* gr = (const f32x4*)gain + lane;
    f32x4 v[8]; float s = 0.f;
#pragma unroll
    for (int j = 0; j < 8; ++j) { v[j] = xr[64 * j]; s += (v[j].x * v[j].x + v[j].y * v[j].y) + (v[j].z * v[j].z + v[j].w * v[j].w); }
    const float rstd = 1.0f / sqrtf(wave_sum(s) * (1.0f / 2048.0f) + RMS_EPS);
    u32x2* o8 = (u32x2*)orow + lane;
#pragma unroll
    for (int j = 0; j < 8; ++j) { const f32x4 g = gr[64 * j]; u32x2 w; w.x = cvtpk(v[j].x * rstd * g.x, v[j].y * rstd * g.y); w.y = cvtpk(v[j].z * rstd * g.z, v[j].w * rstd * g.w); o8[64 * j] = w; }
}
__device__ __forceinline__ float row_to_bf16_ss(const float* xrow, bf16_t* orow, int lane) {
    const f32x4* xr = (const f32x4*)xrow + lane; u32x2* o8 = (u32x2*)orow + lane; float s = 0.f;
#pragma unroll
    for (int j = 0; j < 8; ++j) { const f32x4 v = xr[64 * j]; s += (v.x * v.x + v.y * v.y) + (v.z * v.z + v.w * v.w); u32x2 w; w.x = cvtpk(v.x, v.y); w.y = cvtpk(v.z, v.w); o8[64 * j] = w; }
    return wave_sum(s);
}
__device__ __forceinline__ void rms_row_bf16in_f32(const bf16_t* xrow, const float* gain, float* orow, int lane) {
    const u32x4* xr = (const u32x4*)xrow + lane; float v[4][8]; float s = 0.f;
#pragma unroll
    for (int j = 0; j < 4; ++j) { unpack8(xr[64 * j], v[j]);
#pragma unroll
        for (int e = 0; e < 8; ++e) s += v[j][e] * v[j][e]; }
    const float rstd = 1.0f / sqrtf(wave_sum(s) * (1.0f / 2048.0f) + RMS_EPS);
#pragma unroll
    for (int j = 0; j < 4; ++j) { const int c0 = 8 * (lane + 64 * j); const f32x4 g0 = *(const f32x4*)(gain + c0), g1 = *(const f32x4*)(gain + c0 + 4);
        *(f32x4*)(orow + c0) = (f32x4){v[j][0] * rstd * g0.x, v[j][1] * rstd * g0.y, v[j][2] * rstd * g0.z, v[j][3] * rstd * g0.w};
        *(f32x4*)(orow + c0 + 4) = (f32x4){v[j][4] * rstd * g1.x, v[j][5] * rstd * g1.y, v[j][6] * rstd * g1.z, v[j][7] * rstd * g1.w}; }
}

constexpr float SM_SCALE = 0.08838834764831845f;
constexpr float SM_C = SM_SCALE * 1.4426950408889634f;
constexpr float NEGM = -3.0e38f, M_INIT = -1.0e30f;
constexpr float SM_THR = 8.0f / SM_SCALE;

struct KVStage { u32x4 k0, k1, v0, v1; };
__device__ __forceinline__ void kv_load(KVStage& s, const bf16_t* kp, const bf16_t* vp, size_t ld, int tid) {
    const int r0 = tid >> 4, c = (tid & 15) * 8;
    s.k0 = *(const u32x4*)(kp + (size_t)r0 * ld + c); s.k1 = *(const u32x4*)(kp + (size_t)(r0 + 32) * ld + c);
    s.v0 = *(const u32x4*)(vp + (size_t)r0 * ld + c); s.v1 = *(const u32x4*)(vp + (size_t)(r0 + 32) * ld + c);
}
__device__ __forceinline__ void kv_write(const KVStage& s, LAS unsigned char* kb, LAS unsigned char* vb, int tid) {
    const unsigned r0 = tid >> 4, ch = tid & 15;
    *(LAS u32x4*)(kb + offb(r0, ch)) = s.k0; *(LAS u32x4*)(kb + offb(r0 + 32, ch)) = s.k1;
    *(LAS u32x4*)(vb + offb(r0, ch)) = s.v0; *(LAS u32x4*)(vb + offb(r0 + 32, ch)) = s.v1;
}
constexpr int RK0 = 0, RV0 = 49152, KVR = 16384;
constexpr int R4K0 = 0, R4V0 = 65536;
__device__ __forceinline__ unsigned kv_dma_off(int w, int lane, unsigned ldb  ) {
    const unsigned row = 4u * (unsigned)w + ((unsigned)lane >> 4), ch = ((unsigned)lane & 15u) ^ (((row & 3u) << 2) | ((row >> 2) & 3u));
    return row * ldb + 16u * ch;
}
__device__ __forceinline__ void kv_dma_to(const bf16_t* kp, const bf16_t* vp, unsigned off, unsigned ld32b, LAS unsigned char* kb, LAS unsigned char* vb);
__device__ __forceinline__ void kv_dma(const bf16_t* kp, const bf16_t* vp, unsigned off, unsigned ld32b  , LAS unsigned char* lds, int stage, int w) {
    kv_dma_to(kp, vp, off, ld32b, lds + RK0 + stage * KVR + 1024 * w, lds + RV0 + stage * KVR + 1024 * w);
}
__device__ __forceinline__ void kv_dma_to(const bf16_t* kp, const bf16_t* vp, unsigned off, unsigned ld32b, LAS unsigned char* kb, LAS unsigned char* vb) {
    __builtin_amdgcn_global_load_lds((const unsigned*)((const char*)kp + off), (LAS unsigned*)kb, 16, 0, 0);
    __builtin_amdgcn_global_load_lds((const unsigned*)((const char*)kp + off + ld32b), (LAS unsigned*)(kb + 8192), 16, 0, 0);
    __builtin_amdgcn_global_load_lds((const unsigned*)((const char*)vp + off), (LAS unsigned*)vb, 16, 0, 0);
    __builtin_amdgcn_global_load_lds((const unsigned*)((const char*)vp + off + ld32b), (LAS unsigned*)(vb + 8192), 16, 0, 0);
}
#define RING_WAIT(has_next) do { if (has_next) asm volatile("s_waitcnt vmcnt(4)" ::: "memory"); else asm volatile("s_waitcnt vmcnt(0)" ::: "memory"); \
        __builtin_amdgcn_s_barrier(); asm volatile("" ::: "memory"); } while (0)
__device__ __forceinline__ void q_load(bf16x8 (&qr)[8], const bf16_t* qrow, int hi) {
#pragma unroll
    for (int s = 0; s < 8; ++s) qr[s] = *(const bf16x8*)(qrow + 16 * s + 8 * hi);
}
template <int HALF> __device__ __forceinline__ void qk_half(f32x16& p, LAS const unsigned char* kb, const bf16x8 (&qr)[8], int r32, int hi) {
    const f32x16 z = {0.f, 0.f, 0.f, 0.f, 0.f, 0.f, 0.f, 0.f, 0.f, 0.f, 0.f, 0.f, 0.f, 0.f, 0.f, 0.f};
    bf16x8 a[8];
#pragma unroll
    for (int s = 0; s < 8; ++s) a[s] = *(LAS const bf16x8*)(kb + offb(32 * HALF + r32, 2 * s + hi));
    __builtin_amdgcn_s_setprio(1);
    f32x16 pa = MFMA32(a[0], qr[0], z), pb = MFMA32(a[1], qr[1], z);
#pragma unroll
    for (int s = 2; s < 8; s += 2) { pa = MFMA32(a[s], qr[s], pa); pb = MFMA32(a[s + 1], qr[s + 1], pb); }
    __builtin_amdgcn_s_setprio(0);
#pragma unroll
    for (int i = 0; i < 16; ++i) p[i] = pa[i] + pb[i];
}
struct VAddr { unsigned pre[4][2]; };
__device__ __forceinline__ void vaddr_init(VAddr& va, int lane) {
    const unsigned hi = lane >> 5, blk = (lane >> 4) & 1, q = (lane & 15) >> 2, p = lane & 3;
#pragma unroll
    for (int t = 0; t < 2; ++t) {
        const unsigned lowx = (2 * blk + (p >> 1)) ^ ((2 * t + hi) & 3);
        const unsigned base = 2048u * t + 256u * (4 * hi + q) + 16u * lowx + 8u * (p & 1);
#pragma unroll
        for (int c = 0; c < 4; ++c) va.pre[c][t] = base + 64u * ((unsigned)c ^ q);
    }
}
__device__ __forceinline__ void softmax_update(f32x16& p, float& m, float& l, f32x16 (&o)[4], bool en = true) {
    float pmax = fmaxf(p[0], p[1]);
#pragma unroll
    for (int i = 2; i < 16; i += 2) pmax = fmaxf(fmaxf(pmax, p[i]), p[i + 1]);
    pmax = xhalf_max(pmax);
    pmax = en ? pmax : NEGM;
    if (!__all(pmax - m <= SM_THR)) {
        const float mn = fmaxf(m, pmax); const float alpha = fast_exp2((m - mn) * SM_C); m = mn; l *= alpha;
#pragma unroll
        for (int c = 0; c < 4; ++c)
#pragma unroll
            for (int i = 0; i < 16; ++i) o[c][i] *= alpha;
    }
    const float cs = en ? SM_C : 0.f, mc = en ? -m * SM_C : -1.0e30f;
    const f32x2_t cs2 = {cs, cs}, mc2 = {mc, mc}; f32x2_t ps2 = {0.f, 0.f};
#pragma unroll
    for (int i = 0; i < 16; i += 2) { f32x2_t x = {p[i], p[i + 1]}; x = __builtin_elementwise_fma(x, cs2, mc2); x.x = fast_exp2(x.x); x.y = fast_exp2(x.y); p[i] = x.x; p[i + 1] = x.y; ps2 += x; }
    l += xhalf_sum(ps2.x + ps2.y);
}
template <int HALF> __device__ __forceinline__ void pv_half(f32x16 (&o)[4], const f32x16& p, unsigned vb, const VAddr& va) {
    bf16x8 pa[2];
    pa[0] = pack8(p[0], p[1], p[2], p[3], p[4], p[5], p[6], p[7]);
    pa[1] = pack8(p[8], p[9], p[10], p[11], p[12], p[13], p[14], p[15]);
    s16x4 l0[4], h0[4], l1[4], h1[4];
#pragma unroll
    for (int c = 0; c < 4; ++c) { const unsigned a0 = vb + va.pre[c][0], a1 = vb + va.pre[c][1];
        l0[c] = tr_read<8192 * HALF>(a0); h0[c] = tr_read<8192 * HALF>(a1); l1[c] = tr_read<8192 * HALF + 4096>(a0); h1[c] = tr_read<8192 * HALF + 4096>(a1); }
    LGKM_WAIT0();
    __builtin_amdgcn_s_setprio(1);
#pragma unroll
    for (int c = 0; c < 4; ++c) o[c] = MFMA32(PK8(l0[c], h0[c]), pa[0], o[c]);
#pragma unroll
    for (int c = 0; c < 4; ++c) o[c] = MFMA32(PK8(l1[c], h1[c]), pa[1], o[c]);
    __builtin_amdgcn_s_setprio(0);
}
struct SmState { float cs, mc, alpha; };
__device__ __forceinline__ bool sm_begin(const f32x16& p, bool en, float& m, SmState& s) {
    float pmax = fmaxf(p[0], p[1]);
#pragma unroll
    for (int i = 2; i < 16; i += 2) pmax = fmaxf(fmaxf(pmax, p[i]), p[i + 1]);
    pmax = xhalf_max(pmax);
    pmax = en ? pmax : NEGM;
    const bool resc = !__all(pmax - m <= SM_THR);
    const float mn = resc ? fmaxf(m, pmax) : m;
    s.alpha = fast_exp2((m - mn) * SM_C); m = mn;
    s.cs = en ? SM_C : 0.f; s.mc = en ? -mn * SM_C : -1.0e30f;
    return resc;
}
__device__ __forceinline__ void sm_finish(f32x16& p, const SmState& s, float& l, bf16x8 (&pa)[2]) {
    const f32x2_t cs2 = {s.cs, s.cs}, mc2 = {s.mc, s.mc}; f32x2_t ps2 = {0.f, 0.f};
#pragma unroll
    for (int i = 0; i < 16; i += 2) { f32x2_t x = {p[i], p[i + 1]}; x = __builtin_elementwise_fma(x, cs2, mc2); x.x = fast_exp2(x.x); x.y = fast_exp2(x.y); p[i] = x.x; p[i + 1] = x.y; ps2 += x; }
    l = l * s.alpha + xhalf_sum(ps2.x + ps2.y);
    pa[0] = pack8(p[0], p[1], p[2], p[3], p[4], p[5], p[6], p[7]);
    pa[1] = pack8(p[8], p[9], p[10], p[11], p[12], p[13], p[14], p[15]);
}
__device__ __forceinline__ s16x4 tr_rd(unsigned addr) { return __builtin_amdgcn_ds_read_tr16_b64_v4i16((LAS s16x4*)(uintptr_t)addr); }
template <int HALF> __device__ __forceinline__ void pv_half_pa(f32x16 (&o)[4], const bf16x8 (&pa)[2], unsigned vb, const VAddr& va) {
    s16x4 l0[4], h0[4], l1[4], h1[4];
#pragma unroll
    for (int c = 0; c < 4; ++c) { const unsigned a0 = vb + va.pre[c][0] + 8192 * HALF, a1 = vb + va.pre[c][1] + 8192 * HALF;
        l0[c] = tr_rd(a0); h0[c] = tr_rd(a1); l1[c] = tr_rd(a0 + 4096); h1[c] = tr_rd(a1 + 4096); }
#pragma unroll
    for (int c = 0; c < 4; ++c) o[c] = MFMA32(PK8(l0[c], h0[c]), pa[0], o[c]);
#pragma unroll
    for (int c = 0; c < 4; ++c) o[c] = MFMA32(PK8(l1[c], h1[c]), pa[1], o[c]);
}
__device__ __forceinline__ void o_scale(f32x16 (&o)[4], float alpha) {
#pragma unroll
    for (int c = 0; c < 4; ++c)
#pragma unroll
        for (int i = 0; i < 16; ++i) o[c][i] *= alpha;
}
template <int HALF> __device__ __forceinline__ void qk_half_lean(f32x16& p, LAS const unsigned char* kb, const bf16x8 (&qr)[8], int r32, int hi) {
#pragma unroll
    for (int i = 0; i < 16; ++i) p[i] = 0.f;
#pragma unroll
    for (int s = 0; s < 8; ++s) {
        const bf16x8 a0 = *(LAS const bf16x8*)(kb + offb(32 * HALF + r32, 2 * s + hi));
        p = MFMA32(a0, qr[s], p);
    }
}
template <int HALF> __device__ __forceinline__ void pv_one_lean(f32x16& od, unsigned a0, unsigned a1, const bf16x8 (&pa)[2]) {
    const s16x4 l0 = tr_read<8192 * HALF>(a0), h0 = tr_read<8192 * HALF>(a1), l1 = tr_read<8192 * HALF + 4096>(a0), h1 = tr_read<8192 * HALF + 4096>(a1);
    LGKM_WAIT0();
    od = MFMA32(PK8(l0, h0), pa[0], od); od = MFMA32(PK8(l1, h1), pa[1], od);
}
template <int HALF> __device__ __forceinline__ void pv_half_lean(f32x16 (&o)[4], const f32x16& p, unsigned vb, const VAddr& va) {
    bf16x8 pa[2];
    pa[0] = pack8(p[0], p[1], p[2], p[3], p[4], p[5], p[6], p[7]);
    pa[1] = pack8(p[8], p[9], p[10], p[11], p[12], p[13], p[14], p[15]);
    pv_one_lean<HALF>(o[0], vb + va.pre[0][0], vb + va.pre[0][1], pa);
    pv_one_lean<HALF>(o[1], vb + va.pre[1][0], vb + va.pre[1][1], pa);
    pv_one_lean<HALF>(o[2], vb + va.pre[2][0], vb + va.pre[2][1], pa);
    pv_one_lean<HALF>(o[3], vb + va.pre[3][0], vb + va.pre[3][1], pa);
}
template <bool ACC> __device__ __forceinline__ void o_store(const f32x16 (&o)[4], float sc, bf16_t* orow, int hi) {
    u32x2 old[4][4];
    if (ACC) {
#pragma unroll
        for (int c = 0; c < 4; ++c)
#pragma unroll
            for (int g = 0; g < 4; ++g) old[c][g] = *(const u32x2*)(orow + 32 * c + 8 * g + 4 * hi);
        asm volatile("" ::: "memory");
    }
#pragma unroll
    for (int c = 0; c < 4; ++c)
#pragma unroll
        for (int k = 0; k < 2; ++k) {
            u32x2 w[2];
#pragma unroll
            for (int e = 0; e < 2; ++e) { const int g = 2 * k + e;
                float a0 = o[c][4 * g] * sc, a1 = o[c][4 * g + 1] * sc, a2 = o[c][4 * g + 2] * sc, a3 = o[c][4 * g + 3] * sc;
                if (ACC) { a0 += bflo(old[c][g].x); a1 += bfhi(old[c][g].x); a2 += bflo(old[c][g].y); a3 += bfhi(old[c][g].y); }
                w[e].x = cvtpk(a0, a1); w[e].y = cvtpk(a2, a3); }
            const auto rx = __builtin_amdgcn_permlane32_swap(w[0].x, w[1].x, false, false);
            const auto ry = __builtin_amdgcn_permlane32_swap(w[0].y, w[1].y, false, false);
            u32x4 q; q.x = rx[0]; q.y = ry[0]; q.z = rx[1]; q.w = ry[1];
            *(u32x4*)(orow + 32 * c + 16 * k + 8 * hi) = q;
        }
}
#define O_ZERO(o) do { _Pragma("unroll") for (int _c = 0; _c < 4; ++_c) _Pragma("unroll") for (int _i = 0; _i < 16; ++_i) (o)[_c][_i] = 0.f; } while (0)

constexpr float LOG2_THETA_AB = 18.931568569324174f;
constexpr float LOG2_THETA_RET = 13.287712379549449f;

__device__ __forceinline__ void moba_prep_item(const bf16_t* PROJ, float* KMEAN, int b, int h, int blk, LAS unsigned char* lds, int tid) {
    const int c = tid & 15, tg = tid >> 4; const int tok0 = b * SEQ + 256 * blk + tg * 8;
    LAS float* PART = (LAS float*)lds;
    float csum[8];
#pragma unroll
    for (int j = 0; j < 8; ++j) csum[j] = 0.f;
#pragma unroll
    for (int i = 0; i < 8; ++i) { float x[8]; unpack8(*(const u32x4*)(PROJ + (size_t)(tok0 + i) * AB_PAD + 1024 + h * 128 + 8 * c), x);
#pragma unroll
        for (int j = 0; j < 8; ++j) csum[j] += x[j]; }
#pragma unroll
    for (int j = 0; j < 8; ++j) PART[tg * 128 + 8 * c + j] = csum[j];
    __syncthreads();
    if (tid < 128) { float s = 0.f; for (int g = 0; g < 32; ++g) s += PART[g * 128 + tid]; KMEAN[(((size_t)b * 8 + h) * 16 + blk) * 128 + tid] = s * (1.0f / 256.0f); }
    __syncthreads();
}
__device__ __forceinline__ void compress_item(const bf16_t* PROJ, const float* pe, const bf16_t* w1t  , const bf16_t* w2t  , bf16_t* OUT  ,
                                              int b, int g, int rb, int col0, LAS unsigned char* lds, int tid) {
    const int w = __builtin_amdgcn_readfirstlane(tid >> 6), lane = tid & 63, r32 = lane & 31, hi = lane >> 5;
    int n = 32 * rb + r32; if (n > 254) n = 254;
    const bf16_t* arow = PROJ + (size_t)(b * SEQ + 16 * n) * AB_PAD + col0 + g * 128 + 8 * hi;
    f32x16 acc[4];
#pragma unroll
    for (int c = 0; c < 4; ++c)
#pragma unroll
        for (int i = 0; i < 16; ++i) acc[c][i] = 0.f;
    for (int t = 4 * w; t < 4 * w + 4; ++t) {
#pragma unroll
        for (int s = 0; s < 8; ++s) {
            float x[8]; unpack8(*(const u32x4*)(arow + (size_t)t * AB_PAD + 16 * s), x);
            const f32x4 e0 = *(const f32x4*)(pe + t * 128 + 16 * s + 8 * hi), e1 = *(const f32x4*)(pe + t * 128 + 16 * s + 8 * hi + 4);
            const bf16x8 a = pack8(x[0] + e0.x, x[1] + e0.y, x[2] + e0.z, x[3] + e0.w, x[4] + e1.x, x[5] + e1.y, x[6] + e1.z, x[7] + e1.w);
#pragma unroll
            for (int c = 0; c < 4; ++c) { const bf16x8 bb = *(const bf16x8*)(w1t + ((size_t)(((c * 32 + t) * 8 + s) * 64 + lane)) * 8); acc[c] = MFMA32(a, bb, acc[c]); }
        }
    }
    LAS float* RED = (LAS float*)lds;
    LAS bf16_t* HS = (LAS bf16_t*)(lds + 135168);
    __syncthreads();
#pragma unroll
    for (int c = 0; c < 4; ++c)
#pragma unroll
        for (int i = 0; i < 16; ++i) RED[(w * 32 + crow(i, hi)) * 129 + 32 * c + r32] = acc[c][i];
    __syncthreads();
    { const int row = tid >> 4, c0 = 8 * (tid & 15);
#pragma unroll
      for (int j = 0; j < 8; ++j) { float sacc = 0.f;
#pragma unroll
          for (int ww = 0; ww < 8; ++ww) sacc += RED[(ww * 32 + row) * 129 + c0 + j];
          HS[row * 136 + c0 + j] = f2bf(silu_f(sacc)); } }
    __syncthreads();
    if (w < 4) {
        const int cb = w;
        f32x16 a2;
#pragma unroll
        for (int i = 0; i < 16; ++i) a2[i] = 0.f;
#pragma unroll
        for (int s = 0; s < 8; ++s) {
            const bf16x8 a = *(LAS const bf16x8*)(HS + r32 * 136 + 16 * s + 8 * hi);
            const bf16x8 bb = *(const bf16x8*)(w2t + (size_t)(32 * cb + r32) * 128 + 16 * s + 8 * hi);
            a2 = MFMA32(a, bb, a2);
        }
#pragma unroll
        for (int i = 0; i < 16; ++i) { const int no = 32 * rb + crow(i, hi); OUT[(size_t)no * 128 + 32 * cb + r32] = (no < 255) ? f2bf(a2[i]) : (bf16_t)0; }
    }
    __syncthreads();
}

constexpr int KB0 = 0, VB0 = 32768, KVB = 16384;

template <int HALF> __device__ __forceinline__ void moba_half(f32x16 (&o)[4], float& m, float& l, const bf16x8 (&qr)[8], LAS const unsigned char* kb, unsigned vb, const VAddr& va,
                                                              bool own, bool selected, int tq, int qloc, int w, int r32, int hi) {
    if (own && 64 * tq + 32 * HALF > 32 * w + 31) return;
    f32x16 p; qk_half<HALF>(p, kb, qr, r32, hi);
    if (own) {
        const int lim = qloc - 64 * tq - 32 * HALF - 4 * hi;
#pragma unroll
        for (int i = 0; i < 16; ++i) p[i] = (((i & 3) + 8 * (i >> 2)) <= lim) ? p[i] : NEGM;
    }
    softmax_update(p, m, l, o, own || selected);
    pv_half<HALF>(o, p, vb, va);
}
__device__ __forceinline__ void moba_unit(const bf16_t* PROJ, const float* KMEAN, bf16_t* ATT, int b, int h, int qb, LAS unsigned char* lds, int tid) {
    const int w = __builtin_amdgcn_readfirstlane(tid >> 6), lane = tid & 63, r32 = lane & 31, hi = lane >> 5;
    const int tokb = b * SEQ;
    const int qloc = 32 * w + r32;
    const size_t qtok = (size_t)(tokb + 256 * qb + qloc);
    LAS float* KM = (LAS float*)(lds + KMEAN_OFF);
    LAS unsigned* UNI = (LAS unsigned*)(lds + MISC_OFF + 256);
    __syncthreads();
    { const float* src = KMEAN + ((size_t)b * 8 + h) * 2048; for (int i = tid; i < 2048; i += NTHREADS) KM[i] = src[i]; if (tid == 0) UNI[0] = 0u; }
    bf16x8 qr[8]; q_load(qr, PROJ + qtok * AB_PAD + h * 128, hi);
    __syncthreads();
    unsigned sel = 0u;
    {
        float v0 = -3.0e38f, v1 = -3.0e38f, v2 = -3.0e38f; int i0 = -1, i1 = -1, i2 = -1;
        for (int j = 0; j < qb; ++j) {
            float gsum = 0.f;
#pragma unroll
            for (int s = 0; s < 8; ++s) {
                float x[8]; unpack8(__builtin_bit_cast(u32x4, qr[s]), x);
                const f32x4 k0 = *(LAS const f32x4*)(KM + j * 128 + 16 * s + 8 * hi), k1 = *(LAS const f32x4*)(KM + j * 128 + 16 * s + 8 * hi + 4);
                gsum += (x[0] * k0.x + x[1] * k0.y) + (x[2] * k0.z + x[3] * k0.w) + (x[4] * k1.x + x[5] * k1.y) + (x[6] * k1.z + x[7] * k1.w);
            }
            const float gv = xhalf_sum(gsum);
            const bool a0 = gv > v0, a1 = gv > v1, a2 = gv > v2;
            v2 = a1 ? v1 : (a2 ? gv : v2); i2 = a1 ? i1 : (a2 ? j : i2);
            v1 = a0 ? v0 : (a1 ? gv : v1); i1 = a0 ? i0 : (a1 ? j : i1);
            v0 = a0 ? gv : v0;             i0 = a0 ? j : i0;
        }
        if (i0 >= 0) sel |= 1u << i0;
        if (i1 >= 0) sel |= 1u << i1;
        if (i2 >= 0) sel |= 1u << i2;
    }
    { unsigned u = sel;
      u |= shxu<1>(u); u |= shxu<2>(u); u |= shxu<4>(u); u |= shxu<8>(u); u |= shxu<16>(u);
      { auto rr = __builtin_amdgcn_permlane32_swap(u, u, false, false); u = rr[0] | rr[1]; }
      if (lane == 0) __hip_atomic_fetch_or(UNI, u, __ATOMIC_RELAXED, __HIP_MEMORY_SCOPE_WORKGROUP); }
    __syncthreads();
    const unsigned umask = (unsigned)__builtin_amdgcn_readfirstlane(UNI[0]) | (1u << qb);
    const int nT = 4 * (qb + 1);
    const bf16_t* Kh = PROJ + (size_t)tokb * AB_PAD + 1024 + h * 128; const bf16_t* Vh = PROJ + (size_t)tokb * AB_PAD + 2048 + h * 128;
    VAddr va; vaddr_init(va, lane);
    f32x16 o[4]; O_ZERO(o); float m = M_INIT, l = 0.f;
    const unsigned lbase = (unsigned)(uintptr_t)lds;
    const unsigned doff = kv_dma_off(w, lane, AB_PAD * 2);
    auto nxt_tile = [&](int g) { int n = g + 1; while (n < nT && !((umask >> (n >> 2)) & 1u)) n = ((n >> 2) + 1) << 2; return n < nT ? n : nT - 1; };
    int g0 = 0; while (!((umask >> (g0 >> 2)) & 1u)) g0 = ((g0 >> 2) + 1) << 2;
    int g1 = nxt_tile(g0), g2 = nxt_tile(g1), g3 = nxt_tile(g2);
#define MOBA_DMA(g, stage) kv_dma_to(Kh + (size_t)(g) * 64 * AB_PAD, Vh + (size_t)(g) * 64 * AB_PAD, doff, 32 * AB_PAD * 2, lds + R4K0 + (stage) * KVR + 1024 * w, lds + R4V0 + (stage) * KVR + 1024 * w)
    MOBA_DMA(g0, 0); MOBA_DMA(g1, 1); MOBA_DMA(g2, 2);
    asm volatile("s_waitcnt vmcnt(8)" ::: "memory"); __builtin_amdgcn_s_barrier(); asm volatile("" ::: "memory");
    f32x16 p0, p1; SmState s0, s1; bf16x8 pa[2];
    int stg = 0; bool last = (g0 == nT - 1);
    {
        const int blk = g0 >> 2; const bool own = (blk == qb);
        qk_half_lean<0>(p0, lds + R4K0, qr, r32, hi);
        if (own) { const int lim = qloc - 64 * (g0 & 3) - 4 * hi;
#pragma unroll
            for (int i = 0; i < 16; ++i) p0[i] = (((i & 3) + 8 * (i >> 2)) <= lim) ? p0[i] : NEGM; }
        if (sm_begin(p0, own || ((sel >> blk) & 1u), m, s0)) o_scale(o, s0.alpha);
    }
    for (;;) {
        int lane_ = lane; asm volatile("" : "+v"(lane_)); const int r32 = lane_ & 31, hi = lane_ >> 5;
        LAS const unsigned char* kb = lds + R4K0 + stg * KVR; const unsigned vb = lbase + R4V0 + stg * KVR;
        const int blk = g0 >> 2, tq = g0 & 3; const bool own = (blk == qb); const bool en = own || ((sel >> blk) & 1u);
        qk_half_lean<1>(p1, kb, qr, r32, hi);
        sm_finish(p0, s0, l, pa);
        pv_half_pa<0>(o, pa, vb, va);
        if (own) { const int lim = qloc - 64 * tq - 32 - 4 * hi;
#pragma unroll
            for (int i = 0; i < 16; ++i) p1[i] = (((i & 3) + 8 * (i >> 2)) <= lim) ? p1[i] : NEGM; }
        if (sm_begin(p1, en, m, s1)) o_scale(o, s1.alpha);
        if (last) break;
        asm volatile("s_waitcnt vmcnt(4)" ::: "memory"); __builtin_amdgcn_s_barrier(); asm volatile("" ::: "memory");
        MOBA_DMA(g3, (stg + 3) & 3);
        const int nstg = (stg + 1) & 3;
        {
            const int nblk = g1 >> 2; const bool nown = (nblk == qb);
            qk_half_lean<0>(p0, lds + R4K0 + nstg * KVR, qr, r32, hi);
            sm_finish(p1, s1, l, pa);
            pv_half_pa<1>(o, pa, vb, va);
            if (nown) { const int lim = qloc - 64 * (g1 & 3) - 4 * hi;
#pragma unroll
                for (int i = 0; i < 16; ++i) p0[i] = (((i & 3) + 8 * (i >> 2)) <= lim) ? p0[i] : NEGM; }
            if (sm_begin(p0, nown || ((sel >> nblk) & 1u), m, s0)) o_scale(o, s0.alpha);
        }
        g0 = g1; g1 = g2; g2 = g3; g3 = nxt_tile(g3); stg = nstg; last = (g0 == nT - 1);
    }
    { sm_finish(p1, s1, l, pa); pv_half_pa<1>(o, pa, lbase + R4V0 + stg * KVR, va); }
#undef MOBA_DMA
    asm volatile("s_waitcnt vmcnt(0)" ::: "memory");
    o_store<false>(o, __builtin_amdgcn_rcpf(l), ATT + qtok * D + h * 128, hi);
}

__device__ __forceinline__ void cross_unit(const bf16_t* QX, const bf16_t* MEMKV, bf16_t* AX, int layer, int b, int head, int qb, LAS unsigned char* lds, int tid) {
    const int w = __builtin_amdgcn_readfirstlane(tid >> 6), lane = tid & 63, r32 = lane & 31, hi = lane >> 5;
    const size_t qtok = (size_t)(b * SEQ + 256 * qb + 32 * w + r32);
    const bf16_t* Kh = MEMKV + (size_t)(b * 256) * 4096 + layer * 1024 + head * 128; const bf16_t* Vh = Kh + 512;
    bf16x8 qr[8]; q_load(qr, QX + qtok * 512 + head * 128, hi);
    VAddr va; vaddr_init(va, lane);
    f32x16 o[4]; O_ZERO(o); float m = M_INIT, l = 0.f;
    const unsigned lbase = (unsigned)(uintptr_t)lds;
    const unsigned doff = kv_dma_off(w, lane, 4096 * 2);
    __syncthreads();
    kv_dma(Kh, Vh, doff, 32 * 4096 * 2, lds, 0, w); kv_dma(Kh + (size_t)64 * 4096, Vh + (size_t)64 * 4096, doff, 32 * 4096 * 2, lds, 1, w);
#pragma unroll
    for (int t = 0; t < 4; ++t) {
        const int stg = t % 3;
        RING_WAIT(t + 1 < 4);
        if (t + 2 < 4) kv_dma(Kh + (size_t)(t + 2) * 64 * 4096, Vh + (size_t)(t + 2) * 64 * 4096, doff, 32 * 4096 * 2, lds, (t + 2) % 3, w);
        { f32x16 p; qk_half<0>(p, lds + RK0 + stg * KVR, qr, r32, hi); softmax_update(p, m, l, o); pv_half<0>(o, p, lbase + RV0 + stg * KVR, va); }
        { f32x16 p; qk_half<1>(p, lds + RK0 + stg * KVR, qr, r32, hi); softmax_update(p, m, l, o); pv_half<1>(o, p, lbase + RV0 + stg * KVR, va); }
    }
    o_store<false>(o, __builtin_amdgcn_rcpf(l), AX + qtok * 512 + head * 128, hi);
}

template <class NextF, class DmaF, class MaskF>
__device__ __forceinline__ void ring_attention(f32x16 (&o)[4], float& m, float& l, const bf16x8 (&qr)[8], const VAddr& va, LAS unsigned char* lds, unsigned lbase, int lane,
                                               int gfirst, int glast, NextF next, DmaF dma, MaskF mask) {
    int g0 = gfirst, g1 = next(g0), g2 = next(g1), g3 = next(g2);
    dma(g0, 0); dma(g1, 1); dma(g2, 2);
    asm volatile("s_waitcnt vmcnt(8)" ::: "memory"); __builtin_amdgcn_s_barrier(); asm volatile("" ::: "memory");
    f32x16 p0, p1; SmState s0, s1; bf16x8 pa[2];
    int stg = 0; bool last = (g0 == glast);
    { int lane_ = lane; asm volatile("" : "+v"(lane_)); const int r32 = lane_ & 31, hi = lane_ >> 5;
      qk_half_lean<0>(p0, lds + R4K0, qr, r32, hi);
      const bool en = mask(g0, 0, p0);
      if (sm_begin(p0, en, m, s0)) o_scale(o, s0.alpha); }
    for (;;) {
        int lane_ = lane; asm volatile("" : "+v"(lane_)); const int r32 = lane_ & 31, hi = lane_ >> 5;
        LAS const unsigned char* kb = lds + R4K0 + stg * KVR; const unsigned vb = lbase + R4V0 + stg * KVR;
        qk_half_lean<1>(p1, kb, qr, r32, hi);
        sm_finish(p0, s0, l, pa);
        pv_half_pa<0>(o, pa, vb, va);
        { const bool en = mask(g0, 1, p1); if (sm_begin(p1, en, m, s1)) o_scale(o, s1.alpha); }
        if (last) break;
        asm volatile("s_waitcnt vmcnt(4)" ::: "memory"); __builtin_amdgcn_s_barrier(); asm volatile("" ::: "memory");
        dma(g3, (stg + 3) & 3);
        const int nstg = (stg + 1) & 3;
        qk_half_lean<0>(p0, lds + R4K0 + nstg * KVR, qr, r32, hi);
        sm_finish(p1, s1, l, pa);
        pv_half_pa<1>(o, pa, vb, va);
        { const bool en = mask(g1, 0, p0); if (sm_begin(p0, en, m, s0)) o_scale(o, s0.alpha); }
        g0 = g1; g1 = g2; g2 = g3; g3 = next(g3); stg = nstg; last = (g0 == glast);
    }
    { sm_finish(p1, s1, l, pa); pv_half_pa<1>(o, pa, lbase + R4V0 + stg * KVR, va); }
    asm volatile("s_waitcnt vmcnt(0)" ::: "memory");
}

constexpr int IMPH_OFF = 65536;
template <int HALF> __device__ __forceinline__ void cmp_stats_half(float& m, float& l, const bf16x8 (&qr)[8], LAS const unsigned char* kb, int t, int nmax, int r32, int hi) {
    f32x16 p; qk_half_lean<HALF>(p, kb, qr, r32, hi);
    float pmax = NEGM;
#pragma unroll
    for (int i = 0; i < 16; ++i) { const int n = 64 * t + 32 * HALF + crow(i, hi); p[i] = (n <= nmax) ? p[i] : NEGM; pmax = fmaxf(pmax, p[i]); }
    pmax = xhalf_max(pmax);
    const float mn = fmaxf(m, pmax); float ps = 0.f; const float mc = -mn * SM_C;
#pragma unroll
    for (int i = 0; i < 16; ++i) ps += fast_exp2(fmaf(p[i], SM_C, mc));
    l = l * fast_exp2((m - mn) * SM_C) + xhalf_sum(ps); m = mn;
}
template <int HALF> __device__ __forceinline__ void cmp_acc_half(f32x16 (&o)[4], float& prevT, const bf16x8 (&qr)[8], LAS const unsigned char* kb, unsigned vb, const VAddr& va, LAS float* IMPH,
                                                                 int t, int nmax, float mc, float inv_l, int r, int tokl, int r32, int hi) {
    f32x16 p; qk_half_lean<HALF>(p, kb, qr, r32, hi);
#pragma unroll
    for (int i = 0; i < 16; ++i) { const int n = 64 * t + 32 * HALF + crow(i, hi); p[i] = (n <= nmax) ? fast_exp2(fmaf(p[i], SM_C, mc)) : 0.f; }
#pragma unroll
    for (int gi = 0; gi < 4; ++gi) {
        const float gs = (p[4 * gi] + p[4 * gi + 1]) + (p[4 * gi + 2] + p[4 * gi + 3]);
        const float T = xhalf_get(p[4 * gi + 3], hi);
        const float val = gs + (hi ? T : prevT); prevT = T;
        const int a = 16 * t + 8 * HALF + 2 * gi + hi;
        IMPH[(r * 64 + a) * 64 + tokl] = val * inv_l;
    }
    pv_half_lean<HALF>(o, p, vb, va);
}
template <int HALF> __device__ __forceinline__ void sel_half(f32x16 (&o)[4], float& m, float& l, const bf16x8 (&qr)[8], LAS const unsigned char* kb, unsigned vb, const VAddr& va,
                                                             bool sel, bool own, int tokl, int r32, int hi) {
    f32x16 p; qk_half_lean<HALF>(p, kb, qr, r32, hi);
    if (own) {
        const int lim = tokl - 32 * HALF - 4 * hi;
#pragma unroll
        for (int i = 0; i < 16; ++i) p[i] = (((i & 3) + 8 * (i >> 2)) <= lim) ? p[i] : NEGM;
    }
    softmax_update(p, m, l, o, sel);
    pv_half_lean<HALF>(o, p, vb, va);
}
template <int HALF> __device__ __forceinline__ void win_half(f32x16 (&o)[4], float& m, float& l, const bf16x8 (&qr)[8], LAS const unsigned char* kb, unsigned vb, const VAddr& va,
                                                             bool edge, int pos, int j, int r32, int hi) {
    f32x16 p; qk_half_lean<HALF>(p, kb, qr, r32, hi);
    if (edge) {
#pragma unroll
        for (int i = 0; i < 16; ++i) { const int dist = pos - (64 * j + 32 * HALF + crow(i, hi)); p[i] = (dist >= 0 && dist < 512) ? p[i] : NEGM; }
    }
    softmax_update(p, m, l, o);
    pv_half_lean<HALF>(o, p, vb, va);
}
__device__ __forceinline__ void nsa_unit(const bf16_t* PROJ, const bf16_t* NQROT, const bf16_t* KC, const bf16_t* VC, bf16_t* ATT, int b, int g, int tt, LAS unsigned char* lds, int tid) {
    const int w = __builtin_amdgcn_readfirstlane(tid >> 6), lane = tid & 63, r32 = lane & 31, hi = lane >> 5;
    const int r = w >> 1, tokl = 32 * (w & 1) + r32, head = 4 * g + r;
    const int pos = 64 * tt + tokl;
    const size_t tok = (size_t)(b * SEQ + pos);
    bf16_t* orow = ATT + tok * D + 1024 + head * 128;
    const bf16_t* gatep = PROJ + tok * AB_PAD + 5632 + head * 3;
    const unsigned lbase = (unsigned)(uintptr_t)lds;
    LAS float* IMPH = (LAS float*)(lds + IMPH_OFF);
    LAS float* IMPF = (LAS float*)lds;
    LAS unsigned long long* SELM = (LAS unsigned long long*)(lds + SELM_OFF);
    LAS unsigned long long* UNI8 = (LAS unsigned long long*)(lds + MISC_OFF + 512);
    bf16x8 qr[8]; f32x16 o[4]; KVStage st; float m, l;
    __syncthreads();
    {
        q_load(qr, PROJ + tok * AB_PAD + 3072 + head * 128, hi);
        VAddr va; vaddr_init(va, lane);
        const bf16_t* Kh = KC + (size_t)(b * 2 + g) * 256 * 128; const bf16_t* Vh = VC + (size_t)(b * 2 + g) * 256 * 128;
        const int nmax = (pos >= 31) ? ((pos - 31) >> 4) : -1;
        m = M_INIT; l = 0.f;
        { int tid1 = tid; asm volatile("" : "+v"(tid1)); const int r0 = tid1 >> 4, c = (tid1 & 15) * 8;
#pragma unroll
          for (int tb = 0; tb < 4; tb += 2) { u32x4 ka[2][2];
#pragma unroll
              for (int t = 0; t < 2; ++t) { ka[t][0] = *(const u32x4*)(Kh + (size_t)((tb + t) * 64 + r0) * 128 + c); ka[t][1] = *(const u32x4*)(Kh + (size_t)((tb + t) * 64 + r0 + 32) * 128 + c); }
#pragma unroll
              for (int t = 0; t < 2; ++t) { *(LAS u32x4*)(lds + (tb + t) * KVB + offb(r0, tid1 & 15)) = ka[t][0]; *(LAS u32x4*)(lds + (tb + t) * KVB + offb(r0 + 32, tid1 & 15)) = ka[t][1]; } } }
        __syncthreads();
#pragma unroll
        for (int t = 0; t < 4; ++t) {
            cmp_stats_half<0>(m, l, qr, lds + t * KVB, t, nmax, r32, hi);
            cmp_stats_half<1>(m, l, qr, lds + t * KVB, t, nmax, r32, hi);
        }
        __syncthreads();
        int buf = 0;
        const float inv_l = (l > 0.f) ? 1.0f / l : 0.f; const float mc = -m * SM_C;
        O_ZERO(o);
        kv_load(st, Kh, Vh, 128, tid); kv_write(st, lds + KB0, lds + VB0, tid);
        __syncthreads();
        buf = 0; float prevT = 0.f;
        for (int t = 0; t < 4; ++t) {
            if (t + 1 < 4) kv_load(st, Kh + (size_t)(t + 1) * 64 * 128, Vh + (size_t)(t + 1) * 64 * 128, 128, tid);
            cmp_acc_half<0>(o, prevT, qr, lds + KB0 + buf * KVB, lbase + VB0 + buf * KVB, va, IMPH, t, nmax, mc, inv_l, r, tokl, r32, hi);
            cmp_acc_half<1>(o, prevT, qr, lds + KB0 + buf * KVB, lbase + VB0 + buf * KVB, va, IMPH, t, nmax, mc, inv_l, r, tokl, r32, hi);
            if (t + 1 < 4) kv_write(st, lds + KB0 + (buf ^ 1) * KVB, lds + VB0 + (buf ^ 1) * KVB, tid);
            __syncthreads();
            buf ^= 1;
        }
        o_store<false>(o, inv_l * sigmoid_f(bf2f(gatep[0])), orow, hi);
        int tid3 = tid; asm volatile("" : "+v"(tid3));
#pragma unroll
        for (int i = 0; i < 8; ++i) { const int e = tid3 + NTHREADS * i, tl = e & 63, a = e >> 6;
            IMPF[tl * 65 + a] = ((IMPH[(0 * 64 + a) * 64 + tl] + IMPH[(1 * 64 + a) * 64 + tl]) + IMPH[(2 * 64 + a) * 64 + tl]) + IMPH[(3 * 64 + a) * 64 + tl]; }
        __syncthreads();
        unsigned long long uni = 0ull;
        for (int i = 0; i < 8; ++i) {
            const int tl = 8 * w + i; const float v = IMPF[tl * 65 + lane];
            const bool forced = (lane == 0) || (lane == tt) || (lane == tt - 1);
            const bool valid = lane <= tt;
            const unsigned key = !valid ? 0u : (forced ? 0x7f000000u : (__float_as_uint(fmaxf(v, 0.f)) + 1u));
            unsigned T = 0u;
#pragma unroll 4
            for (int bit = 30; bit >= 0; --bit) { const unsigned cand = T | (1u << bit); if (__popcll(__ballot(key >= cand)) >= 16) T = cand; }
            const unsigned long long gt = __ballot(key > T);
            unsigned long long ties = __ballot(key == T && valid);
            int need = 16 - __popcll(gt); unsigned long long pick = 0ull;
            while (need > 0 && ties) { const unsigned long long low = ties & (0ull - ties); pick |= low; ties ^= low; --need; }
            const unsigned long long msk = gt | pick;
            if (lane == 0) SELM[tl] = msk;
            uni |= msk;
        }
        if (lane == 0) UNI8[w] = uni;
        __syncthreads();
    }
    int tid2 = tid; asm volatile("" : "+v"(tid2));
    const int lane2 = tid2 & 63, r32b = lane2 & 31, hib = lane2 >> 5, tokl2 = 32 * (w & 1) + r32b, pos2 = 64 * tt + tokl2;
    const size_t tok2 = (size_t)(b * SEQ + pos2);
    bf16_t* orow2 = ATT + tok2 * D + 1024 + head * 128;
    const bf16_t* gatep2 = PROJ + tok2 * AB_PAD + 5632 + head * 3;
    VAddr va; vaddr_init(va, lane2);
    const unsigned long long selm = SELM[tokl2];
    unsigned long long umask = 0ull;
#pragma unroll
    for (int i = 0; i < 8; ++i) umask |= UNI8[i];
    umask = ((unsigned long long)(unsigned)__builtin_amdgcn_readfirstlane((unsigned)(umask >> 32)) << 32) | (unsigned)__builtin_amdgcn_readfirstlane((unsigned)umask);
    q_load(qr, NQROT + tok2 * 1024 + head * 128, hib);
    const unsigned doff = kv_dma_off(w, lane2, AB_PAD * 2);
    {
        const bf16_t* Kh = PROJ + (size_t)(b * SEQ) * AB_PAD + 4608 + g * 128; const bf16_t* Vh = PROJ + (size_t)(b * SEQ) * AB_PAD + 4864 + g * 128;
        O_ZERO(o); m = M_INIT; l = 0.f;
        int jf = 0; while (jf < tt && !((umask >> jf) & 1ull)) ++jf;
        ring_attention(o, m, l, qr, va, lds, lbase, lane2, jf, tt,
            [&](int j) { int n = j + 1; while (n < tt && !((umask >> n) & 1ull)) ++n; return n < tt ? n : tt; },
            [&](int j, int stage) { kv_dma_to(Kh + (size_t)j * 64 * AB_PAD, Vh + (size_t)j * 64 * AB_PAD, doff, 32 * AB_PAD * 2, lds + R4K0 + stage * KVR + 1024 * w, lds + R4V0 + stage * KVR + 1024 * w); },
            [&](int j, int half, f32x16& p) {
                if (j == tt) {
                    const int lim = tokl2 - 32 * half - 4 * hib;
#pragma unroll
                    for (int i = 0; i < 16; ++i) p[i] = (((i & 3) + 8 * (i >> 2)) <= lim) ? p[i] : NEGM; }
                return (bool)((selm >> j) & 1ull); });
        o_store<true>(o, __builtin_amdgcn_rcpf(l) * sigmoid_f(bf2f(gatep2[1])), orow2, hib);
    }
    __syncthreads();
    {
        const bf16_t* Kh = PROJ + (size_t)(b * SEQ) * AB_PAD + 5120 + g * 128; const bf16_t* Vh = PROJ + (size_t)(b * SEQ) * AB_PAD + 5376 + g * 128;
        O_ZERO(o); m = M_INIT; l = 0.f;
        const int j0 = (tt >= 8) ? tt - 8 : 0;
        ring_attention(o, m, l, qr, va, lds, lbase, lane2, j0, tt,
            [&](int j) { return j < tt ? j + 1 : tt; },
            [&](int j, int stage) { kv_dma_to(Kh + (size_t)j * 64 * AB_PAD, Vh + (size_t)j * 64 * AB_PAD, doff, 32 * AB_PAD * 2, lds + R4K0 + stage * KVR + 1024 * w, lds + R4V0 + stage * KVR + 1024 * w); },
            [&](int j, int half, f32x16& p) {
                if ((j == tt) || (j == tt - 8)) {
#pragma unroll
                    for (int i = 0; i < 16; ++i) { const int dist = pos2 - (64 * j + 32 * half + crow(i, hib)); p[i] = (dist >= 0 && dist < 512) ? p[i] : NEGM; } }
                return true; });
        o_store<true>(o, __builtin_amdgcn_rcpf(l) * sigmoid_f(bf2f(gatep2[2])), orow2, hib);
    }
}

__device__ __forceinline__ void phase_conv_fixup(const bf16_t* UH, const float* cw  , const float* cb  , bf16_t* ACT, int gtid, int ngt) {
    constexpr int NCH = DFF / 8;
    const int nitems = (M / 256) * NCH;
    for (int it = gtid; it < nitems; it += ngt) {
        const int pm = it / NCH, ch = it - pm * NCH, n0 = 8 * ch;
        if ((pm & 15) == 0) continue;
        float g[4][8], v[4][8];
        unpack8(*(const u32x4*)(UH + ((size_t)(pm - 1) * 4 + 2) * DFF2 + n0), g[0]); unpack8(*(const u32x4*)(UH + ((size_t)(pm - 1) * 4 + 3) * DFF2 + n0), g[1]);
        unpack8(*(const u32x4*)(UH + ((size_t)pm * 4 + 0) * DFF2 + n0), g[2]); unpack8(*(const u32x4*)(UH + ((size_t)pm * 4 + 1) * DFF2 + n0), g[3]);
        unpack8(*(const u32x4*)(UH + ((size_t)(pm - 1) * 4 + 2) * DFF2 + DFF + n0), v[0]); unpack8(*(const u32x4*)(UH + ((size_t)(pm - 1) * 4 + 3) * DFF2 + DFF + n0), v[1]);
        unpack8(*(const u32x4*)(UH + ((size_t)pm * 4 + 0) * DFF2 + DFF + n0), v[2]); unpack8(*(const u32x4*)(UH + ((size_t)pm * 4 + 1) * DFF2 + DFF + n0), v[3]);
#pragma unroll
        for (int r = 0; r < 2; ++r) { float a[8];
#pragma unroll
            for (int j = 0; j < 8; ++j) {
                const float cg = cb[n0 + j] + cw[n0 + j] * g[r][j] + cw[DFF2 + n0 + j] * g[r + 1][j] + cw[2 * DFF2 + n0 + j] * g[r + 2][j];
                const float cv = cb[DFF + n0 + j] + cw[DFF + n0 + j] * v[r][j] + cw[DFF2 + DFF + n0 + j] * v[r + 1][j] + cw[2 * DFF2 + DFF + n0 + j] * v[r + 2][j];
                a[j] = silu_f(cg) * cv; }
            *(u32x4*)(ACT + (size_t)(256 * pm + r) * DFF + n0) = packu8(a); }
    }
}

__device__ __forceinline__ void retention_unit(const bf16_t* PROJ, bf16_t* Y, int b, int h, int vs, LAS unsigned char* lds, int tid) {
    const int w = __builtin_amdgcn_readfirstlane(tid >> 6);
    const int nb = (w < 4) ? (w >> 1) : (3 - ((w - 4) >> 1)), jv = w & 1;
    const int tid_in = tid;
    const float lg = log2f(1.0f - exp2f(-5.0f - (float)h));
    const float gC = exp2f(128.0f * lg);
    LAS unsigned char* Kl = lds; LAS unsigned char* Vl = lds + 65536; LAS unsigned char* Pl = lds + 81920; LAS unsigned char* Sl = lds + 114688;
    const unsigned KlA = (unsigned)(uintptr_t)Kl, VlA = (unsigned)(uintptr_t)Vl;
    const bf16_t* base = PROJ + (size_t)(b * SEQ) * C_COLS;
    f32x16 st[2];
#pragma unroll
    for (int i = 0; i < 16; ++i) { st[0][i] = 0.f; st[1][i] = 0.f; }
    u32x4 kst[8], vst[2]; bf16x8 qf[16];
    { int tid = tid_in; asm volatile("" : "+v"(tid)); const int lane = tid & 63, r32 = lane & 31, hi = lane >> 5;
#pragma unroll
    for (int i = 0; i < 8; ++i) { const int e = tid + NTHREADS * i, row = e >> 5, c32 = e & 31; kst[i] = *(const u32x4*)(base + (size_t)row * C_COLS + 2048 + h * 256 + 8 * c32); }
#pragma unroll
    for (int i = 0; i < 2; ++i) { const int e = tid + NTHREADS * i, row = e >> 3, ch = e & 7; vst[i] = *(const u32x4*)(base + (size_t)row * C_COLS + 4096 + h * 512 + 64 * vs + 8 * ch); }
#pragma unroll
    for (int s = 0; s < 16; ++s) qf[s] = *(const bf16x8*)(base + (size_t)(32 * nb + r32) * C_COLS + h * 256 + 16 * s + 8 * hi);
    }
    __syncthreads();
    for (int c = 0; c < 32; ++c) {
        int tid = tid_in; asm volatile("" : "+v"(tid));
        const int lane = tid & 63, r32 = lane & 31, hi = lane >> 5;
        const unsigned tq = (lane & 15) >> 2, tp = lane & 3, tblk = (lane >> 4) & 1;
        const bf16_t* cb = base + (size_t)(128 * c) * C_COLS;
#pragma unroll
        for (int i = 0; i < 8; ++i) { const unsigned e = tid + NTHREADS * i, row = e >> 5, c32 = e & 31; *(LAS u32x4*)(Kl + (c32 >> 4) * 32768 + offb(row, c32 & 15)) = kst[i]; }
#pragma unroll
        for (int i = 0; i < 2; ++i) { const unsigned e = tid + NTHREADS * i, row = e >> 3, ch = e & 7; float x[8]; unpack8(vst[i], x); const float kd = fast_exp2((float)(127 - (int)row) * lg);
#pragma unroll
            for (int j = 0; j < 8; ++j) x[j] *= kd;
            *(LAS u32x4*)(Vl + offv(row, ch)) = packu8(x); }
        asm volatile("s_waitcnt lgkmcnt(0)" ::: "memory"); __builtin_amdgcn_s_barrier(); asm volatile("" ::: "memory");
        if (c + 1 < 32) {
            const bf16_t* nbp = cb + (size_t)128 * C_COLS;
#pragma unroll
            for (int i = 0; i < 8; ++i) { const int e = tid + NTHREADS * i, row = e >> 5, c32 = e & 31; kst[i] = *(const u32x4*)(nbp + (size_t)row * C_COLS + 2048 + h * 256 + 8 * c32); }
#pragma unroll
            for (int i = 0; i < 2; ++i) { const int e = tid + NTHREADS * i, row = e >> 3, ch = e & 7; vst[i] = *(const u32x4*)(nbp + (size_t)row * C_COLS + 4096 + h * 512 + 64 * vs + 8 * ch); }
        }
        {
            const int mb0 = (nb == 1) ? jv : 2 * jv, mb1 = (nb == 1) ? 4 : 2 * jv + 1;
            if (mb0 <= nb) {
                const bool two = (mb1 <= nb);
                f32x16 sa0, sa1;
#pragma unroll
                for (int i = 0; i < 16; ++i) { sa0[i] = 0.f; sa1[i] = 0.f; }
                if (two) {
#pragma unroll
                    for (int s = 0; s < 16; ++s) {
                        const bf16x8 kf0 = *(LAS const bf16x8*)(Kl + (s >> 3) * 32768 + offb(32 * mb0 + r32, 2 * (s & 7) + hi));
                        const bf16x8 kf1 = *(LAS const bf16x8*)(Kl + (s >> 3) * 32768 + offb(32 * mb1 + r32, 2 * (s & 7) + hi));
                        sa0 = MFMA32(qf[s], kf0, sa0); sa1 = MFMA32(qf[s], kf1, sa1);
                    }
                } else {
#pragma unroll
                    for (int s = 0; s < 16; ++s) {
                        const bf16x8 kf0 = *(LAS const bf16x8*)(Kl + (s >> 3) * 32768 + offb(32 * mb0 + r32, 2 * (s & 7) + hi));
                        sa0 = MFMA32(qf[s], kf0, sa0);
                    }
                }
                const int mc0 = 32 * mb0 + r32, mc1 = 32 * mb1 + r32;
#pragma unroll
                for (int j = 0; j < 4; ++j) { const int n0 = 32 * nb + 8 * j + 4 * hi; float x0[4], x1[4];
#pragma unroll
                    for (int e = 0; e < 4; ++e) { const int n = n0 + e; const float f = fast_exp2((float)(n - 127) * lg);
                        x0[e] = (mc0 <= n) ? sa0[4 * j + e] * f : 0.f; x1[e] = (mc1 <= n) ? sa1[4 * j + e] * f : 0.f; }
                    { u32x2 pk; pk.x = cvtpk(x0[0], x0[1]); pk.y = cvtpk(x0[2], x0[3]); *(LAS u32x2*)(Pl + offb(mc0, 4 * nb + j) + 8 * hi) = pk; }
                    if (two) { u32x2 pk; pk.x = cvtpk(x1[0], x1[1]); pk.y = cvtpk(x1[2], x1[3]); *(LAS u32x2*)(Pl + offb(mc1, 4 * nb + j) + 8 * hi) = pk; } }
            }
        }

        f32x16 oacc;
#pragma unroll
        for (int i = 0; i < 16; ++i) oacc[i] = 0.f;
        if (c > 0) {
#pragma unroll
            for (int s = 0; s < 16; ++s) {
                const bf16x8 sf = *(LAS const bf16x8*)(Sl + (s >> 3) * 16384 + offb(32 * jv + r32, 2 * (s & 7) + hi));
                oacc = MFMA32(qf[s], sf, oacc);
            }
#pragma unroll
            for (int i = 0; i < 16; ++i) oacc[i] *= fast_exp2((float)(32 * nb + crow(i, hi) + 1) * lg);
        }
        if (c + 1 < 32) {
            const bf16_t* nbp = cb + (size_t)128 * C_COLS;
#pragma unroll
            for (int s = 0; s < 16; ++s) qf[s] = *(const bf16x8*)(nbp + (size_t)(32 * nb + r32) * C_COLS + h * 256 + 16 * s + 8 * hi);
        }
        asm volatile("s_waitcnt lgkmcnt(0)" ::: "memory"); __builtin_amdgcn_s_barrier(); asm volatile("" ::: "memory");
        for (int mb = 0; mb <= nb; ++mb) {
#pragma unroll
            for (int s2 = 0; s2 < 2; ++s2) {
                const unsigned row0 = 32 * mb + 16 * s2 + 8 * hi + tq, chv = 4 * jv + 2 * tblk + (tp >> 1), chp = 4 * nb + 2 * tblk + (tp >> 1);
                const unsigned PlA = (unsigned)(uintptr_t)Pl;
                const s16x4 plo = tr_read0(PlA + offb(row0, chp) + 8 * (tp & 1)), phi = tr_read0(PlA + offb(row0 + 4, chp) + 8 * (tp & 1));
                const bf16x8 pf = PK8(plo, phi);
                const s16x4 lo = tr_read0(VlA + offv(row0, chv) + 8 * (tp & 1)), hh = tr_read0(VlA + offv(row0 + 4, chv) + 8 * (tp & 1));
                LGKM_WAIT0();
                oacc = MFMA32(pf, PK8(lo, hh), oacc);
            }
        }
        { bf16_t* yo = Y + (size_t)(b * SEQ + 128 * c + 32 * nb) * 4096 + h * 512 + 64 * vs + 32 * jv + r32;
#pragma unroll
          for (int i = 0; i < 16; ++i) yo[(size_t)crow(i, hi) * 4096] = f2bf(oacc[i]); }

#pragma unroll
        for (int vb = 0; vb < 2; ++vb) {
#pragma unroll
            for (int i = 0; i < 16; ++i) st[vb][i] *= gC;
        }
#pragma unroll
        for (int s2 = 0; s2 < 4; ++s2) {
            const unsigned chk = 4 * (w & 3) + 2 * tblk + (tp >> 1), cv0 = 2 * tblk + (tp >> 1), cv1 = 4 + 2 * tblk + (tp >> 1), kb_ = KlA + (w >> 2) * 32768 + 8 * (tp & 1), vb_ = VlA + 8 * (tp & 1);
            const unsigned ra = 32 * s2 + 8 * hi + tq, rb = ra + 16;
            const s16x4 kal = tr_read0(kb_ + offb(ra, chk)), kah = tr_read0(kb_ + offb(ra + 4, chk)), kbl = tr_read0(kb_ + offb(rb, chk)), kbh = tr_read0(kb_ + offb(rb + 4, chk));
            const s16x4 a0l = tr_read0(vb_ + offv(ra, cv0)), a0h = tr_read0(vb_ + offv(ra + 4, cv0)), a1l = tr_read0(vb_ + offv(ra, cv1)), a1h = tr_read0(vb_ + offv(ra + 4, cv1));
            const s16x4 b0l = tr_read0(vb_ + offv(rb, cv0)), b0h = tr_read0(vb_ + offv(rb + 4, cv0)), b1l = tr_read0(vb_ + offv(rb, cv1)), b1h = tr_read0(vb_ + offv(rb + 4, cv1));
            LGKM_WAIT0();
            const bf16x8 kfa = PK8(kal, kah), kfb = PK8(kbl, kbh);
            st[0] = MFMA32(kfa, PK8(a0l, a0h), st[0]); st[1] = MFMA32(kfa, PK8(a1l, a1h), st[1]);
            st[0] = MFMA32(kfb, PK8(b0l, b0h), st[0]); st[1] = MFMA32(kfb, PK8(b1l, b1h), st[1]);
        }
#pragma unroll
        for (int vb = 0; vb < 2; ++vb)
#pragma unroll
            for (int g = 0; g < 4; ++g) {
                const unsigned dd = (32 * (w & 3) + 8 * g + 4 * hi);
                u32x2 pk; pk.x = cvtpk(st[vb][4 * g], st[vb][4 * g + 1]); pk.y = cvtpk(st[vb][4 * g + 2], st[vb][4 * g + 3]);
                *(LAS u32x2*)(Sl + (w >> 2) * 16384 + offb(32 * vb + r32, dd >> 3) + 2 * (dd & 7)) = pk;
            }
        asm volatile("s_waitcnt lgkmcnt(0)" ::: "memory"); __builtin_amdgcn_s_barrier(); asm volatile("" ::: "memory");
    }
}

__device__ __forceinline__ void phase_gn_gate(bf16_t* Y, const bf16_t* PROJ, const float* gn  , int gw, int ngw, int lane) {
    int rid = gw;
    for (; rid + 3 * ngw < M * 8; rid += 4 * ngw) {
        u32x4 yr[4], gr[4];
#pragma unroll
        for (int k = 0; k < 4; ++k) { const int r = rid + k * ngw, tok = r >> 3, head = r & 7;
            yr[k] = *(const u32x4*)(Y + (size_t)tok * 4096 + head * 512 + 8 * lane); gr[k] = *(const u32x4*)(PROJ + (size_t)tok * C_COLS + 8192 + head * 512 + 8 * lane); }
#pragma unroll
        for (int k = 0; k < 4; ++k) { const int r = rid + k * ngw, tok = r >> 3, head = r & 7;
            float y[8], gg[8]; unpack8(yr[k], y); unpack8(gr[k], gg);
            float s = 0.f;
#pragma unroll
            for (int j = 0; j < 8; ++j) s += y[j];
            const float mu = wave_sum(s) * (1.0f / 512.0f); float q = 0.f;
#pragma unroll
            for (int j = 0; j < 8; ++j) { y[j] -= mu; q += y[j] * y[j]; }
            const float rstd = 1.0f / sqrtf(wave_sum(q) * (1.0f / 512.0f) + RMS_EPS);
            const f32x4 n0 = *(const f32x4*)(gn + head * 512 + 8 * lane), n1 = *(const f32x4*)(gn + head * 512 + 8 * lane + 4);
            const float nn[8] = {n0.x, n0.y, n0.z, n0.w, n1.x, n1.y, n1.z, n1.w};
#pragma unroll
            for (int j = 0; j < 8; ++j) y[j] = silu_f(gg[j]) * (y[j] * rstd * nn[j]);
            *(u32x4*)(Y + (size_t)tok * 4096 + head * 512 + 8 * lane) = packu8(y); }
    }
    for (; rid < M * 8; rid += ngw) {
        const int tok = rid >> 3, head = rid & 7;
        bf16_t* yp = Y + (size_t)tok * 4096 + head * 512 + 8 * lane;
        float y[8], gg[8]; unpack8(*(const u32x4*)yp, y); unpack8(*(const u32x4*)(PROJ + (size_t)tok * C_COLS + 8192 + head * 512 + 8 * lane), gg);
        float s = 0.f;
#pragma unroll
        for (int j = 0; j < 8; ++j) s += y[j];
        const float mu = wave_sum(s) * (1.0f / 512.0f); float q = 0.f;
#pragma unroll
        for (int j = 0; j < 8; ++j) { y[j] -= mu; q += y[j] * y[j]; }
        const float rstd = 1.0f / sqrtf(wave_sum(q) * (1.0f / 512.0f) + RMS_EPS);
        const f32x4 n0 = *(const f32x4*)(gn + head * 512 + 8 * lane), n1 = *(const f32x4*)(gn + head * 512 + 8 * lane + 4);
        const float nn[8] = {n0.x, n0.y, n0.z, n0.w, n1.x, n1.y, n1.z, n1.w};
#pragma unroll
        for (int j = 0; j < 8; ++j) y[j] = silu_f(gg[j]) * (y[j] * rstd * nn[j]);
        *(u32x4*)yp = packu8(y);
    }
}


template <class... T> __device__ __forceinline__ void sk_nop(T...) {}
#ifdef SKIP_CMP
#define SK_CMP(f) sk_nop
#else
#define SK_CMP(f) f
#endif
#ifdef SKIP_MPREP
#define SK_MPREP(f) sk_nop
#else
#define SK_MPREP(f) f
#endif
#ifdef SKIP_NSA
#define SK_NSA(f) sk_nop
#else
#define SK_NSA(f) f
#endif
#ifdef SKIP_MOBA
#define SK_MOBA(f) sk_nop
#else
#define SK_MOBA(f) f
#endif
#ifdef SKIP_RET
#define SK_RET(f) sk_nop
#else
#define SK_RET(f) f
#endif
#ifdef SKIP_CROSS
#define SK_CROSS(f) sk_nop
#else
#define SK_CROSS(f) f
#endif
#ifdef SKIP_CONV
#define SK_CONV(f) sk_nop
#else
#define SK_CONV(f) f
#endif
#ifdef SKIP_GN
#define SK_GN(f) sk_nop
#else
#define SK_GN(f) f
#endif
#ifdef SKIP_GEMM
#define SK_GEMM if (0)
#else
#define SK_GEMM
#endif
__device__ __forceinline__ int launder_v(int x) { asm volatile("" : "+v"(x)); return x; }
__device__ __forceinline__ int launder_s(int x) { asm volatile("" : "+s"(x)); return x; }
__device__ __forceinline__ unsigned char* launder_p(unsigned char* p) { GAS unsigned char* g = (GAS unsigned char*)p; asm volatile("" : "+s"(g)); return (unsigned char*)g; }
#ifndef MK_DUP
#define MK_DUP 0
#endif
#define DUPN(bit) (1 + ((MK_DUP >> (bit)) & 1))
struct Args { const float* in[26]; float* out; unsigned char* ws; int ph_lo, ph_hi; };

__global__ void __launch_bounds__(NTHREADS, 2) fwd_kernel(Args args) {
    extern __shared__ __attribute__((aligned(16))) unsigned char lds_raw[];
    LAS unsigned char* lds = (LAS unsigned char*)lds_raw;
    const int tid0 = threadIdx.x; const int wave0 = __builtin_amdgcn_readfirstlane(tid0 >> 6);
    const int G = gridDim.x, bid = blockIdx.x;
    const int ngw = G * NWAVES, ngt = G * NTHREADS;
    unsigned char* ws0 = args.ws;
    volatile LAS unsigned* MISC = (volatile LAS unsigned*)(lds + MISC_OFF);
    for (int u = tid0; u < 256; u += NTHREADS) MISC[u] = 0u;
    __syncthreads();
    const int lo = args.ph_lo, hi_ph = args.ph_hi;
    XcdBarrier bar; bar.bar = (unsigned*)(ws0 + WS_CTL) + CW_BAR; bar.x = 0; bar.st = nullptr; bar.lead = 0;
    if (hi_ph - lo > 1) bar = xcd_barrier_post((unsigned*)(ws0 + WS_CTL) + CW_BAR, MISC + 8);
#define IN(k) (lo <= (k) && (k) < hi_ph)
#define SEAM(k) do { if (IN(k) && IN((k) + 1)) { XcdBarrier b2_ = bar; b2_.bar = (unsigned*)launder_p((unsigned char*)bar.bar); b2_.x = (unsigned)launder_s((int)bar.x); b2_.lead = (launder_s(wave0) == 0) && ((int)__builtin_amdgcn_mbcnt_hi(~0u, __builtin_amdgcn_mbcnt_lo(~0u, (unsigned)launder_v(0))) == 0); xcd_barrier(b2_); if (DUPN(9) > 1) xcd_barrier(b2_); } } while (0)
#define PHASE_VARS const int lane = (int)__builtin_amdgcn_mbcnt_hi(~0u, __builtin_amdgcn_mbcnt_lo(~0u, (unsigned)launder_v(0))); const int wave = launder_s(wave0); const int tid = wave * 64 + lane; \
    const int gw = bid * NWAVES + wave, gtid = bid * NTHREADS + tid; unsigned char* ws = launder_p(ws0); (void)lane; (void)gw; (void)gtid; (void)ws;

    if (IN(PH_G0)) {
        PHASE_VARS
        LAS float* scr = (LAS float*)(lds + wave * 16640);
        for (int rep = 0; rep < DUPN(4); ++rep) {
        int base = 0;
        for (int e = 0; e < 2; ++e) {
            transpose_matrix(args.in[8] + (size_t)e * 2048 * AB_COLS, args.in[3] + (2 * e) * D, 2048, AB_COLS, AB_PAD, (bf16_t*)(ws + WS_WINAB + e * 23 * MiB), scr, gw, ngw, lane, base);
            transpose_matrix(args.in[15] + (size_t)e * 2048 * 2048, nullptr, 2048, 2048, 2048, (bf16_t*)(ws + WS_WOUTAB + e * 8 * MiB), scr, gw, ngw, lane, base);
            transpose_matrix(args.in[10] + (size_t)e * 4096 * 128, nullptr, 4096, 128, 128, (bf16_t*)(ws + WS_W1K + e * MiB), scr, gw, ngw, lane, base, false, true);
            transpose_matrix(args.in[13] + (size_t)e * 4096 * 128, nullptr, 4096, 128, 128, (bf16_t*)(ws + WS_W1V + e * MiB), scr, gw, ngw, lane, base, false, true);
            transpose_matrix(args.in[11] + (size_t)e * 128 * 128, nullptr, 128, 128, 128, (bf16_t*)(ws + WS_W2K + e * 32768), scr, gw, ngw, lane, base);
            transpose_matrix(args.in[14] + (size_t)e * 128 * 128, nullptr, 128, 128, 128, (bf16_t*)(ws + WS_W2V + e * 32768), scr, gw, ngw, lane, base);
            transpose_matrix(args.in[16] + (size_t)e * 2048 * C_COLS, args.in[3] + (2 * e + 1) * D, 2048, C_COLS, C_COLS, (bf16_t*)(ws + WS_WINC + e * 48 * MiB), scr, gw, ngw, lane, base);
            transpose_matrix(args.in[18] + (size_t)e * 4096 * 2048, nullptr, 4096, 2048, 2048, (bf16_t*)(ws + WS_WOUTC + e * 16 * MiB), scr, gw, ngw, lane, base);
        }
        for (int l = 0; l < 4; ++l) {
            transpose_matrix(args.in[19] + (size_t)l * 2048 * 512, args.in[4] + l * D, 2048, 512, 512, (bf16_t*)(ws + WS_WQX + l * 2 * MiB), scr, gw, ngw, lane, base);
            transpose_matrix(args.in[20] + (size_t)l * 2048 * 1024, nullptr, 2048, 1024, 1024, (bf16_t*)(ws + WS_WKVALL + l * 4 * MiB), scr, gw, ngw, lane, base);
            transpose_matrix(args.in[21] + (size_t)l * 512 * 2048, nullptr, 512, 2048, 2048, (bf16_t*)(ws + WS_WOX + l * 2 * MiB), scr, gw, ngw, lane, base);
            transpose_matrix(args.in[22] + (size_t)l * 2048 * DFF2, args.in[5] + l * D, 2048, DFF2, DFF2, (bf16_t*)(ws + WS_WUP + l * 44 * MiB), scr, gw, ngw, lane, base, true);
            if (l == 0) transpose_matrix(args.in[25] + (size_t)l * DFF * 2048, nullptr, DFF, 2048, 2048, (bf16_t*)(ws + WS_WDOWN + l * 22 * MiB), scr, gw, ngw, lane, base);
        }
        for (int m = gw; m < BATCH * 256; m += ngw) rms_row_bf16(args.in[1] + (size_t)m * D, args.in[6], (bf16_t*)(ws + WS_MEMN) + (size_t)m * D, lane);
        { float* SSP = (float*)(ws + WS_SSP);
          for (int m = gw; m < M; m += ngw) { const float ss = row_to_bf16_ss(args.in[0] + (size_t)m * D, (bf16_t*)(ws + WS_HN) + (size_t)m * D, lane);
              if (lane < 8) SSP[(size_t)lane * M + m] = (lane == 0) ? ss : 0.f; } }
        }
    }
    SEAM(PH_G0);
    for (int layer0 = 0; layer0 < DEPTH; ++layer0) {
        const int layer = launder_s(layer0);
        const int pb = PH_L0 + layer * PH_PER_LAYER;
        const int eo = layer >> 1;
        const bool odd = layer & 1;
        if (IN(pb)) {
            PHASE_VARS
            const int N = odd ? C_COLS : AB_PAD;
            const bf16_t* Wt = odd ? (const bf16_t*)(ws + WS_WINC + eo * 48 * MiB) : (const bf16_t*)(ws + WS_WINAB + eo * 23 * MiB);
            pg8::Gemm g{(const bf16_t*)(ws + WS_HN), Wt, M, N, 2048}; pg8::StaticOrder S; S.init(M, N, G, bid);
            pg8::EpiStoreN E{(bf16_t*)(ws + WS_R1), N, (const float*)(ws + WS_SSP), M, (const int*)args.in[2], odd ? 1 : 2, (bf16_t*)(ws + WS_NQROT)};
            for (int rep = 0; rep < DUPN(6); ++rep) SK_GEMM pg8::gemm_phase<pg8::EpiStoreN, pg8::StaticOrder, true, true>(lds, g, S, E, tid);
            if (layer == 0 && bid >= G - 64) {
                __syncthreads();
                pg8::Gemm g2{(const bf16_t*)(ws + WS_MEMN), (const bf16_t*)(ws + WS_WKVALL), BATCH * 256, 4096, 2048}; pg8::StaticOrder S2; S2.init(BATCH * 256, 4096, 64, bid - (G - 64));
                pg8::EpiStore E2{(bf16_t*)(ws + WS_MEMKV), 4096};
                SK_GEMM pg8::gemm_phase<pg8::EpiStore, pg8::StaticOrder, true, true>(lds, g2, S2, E2, tid);
            }
        }
        SEAM(pb);
        if (!odd) {
            if (IN(pb + 1)) {
                PHASE_VARS
                const bf16_t* PROJ = (const bf16_t*)(ws + WS_R1);
                for (int rep = 0; rep < DUPN(7); ++rep)
                for (int it = bid; it < 640; it += G) {
                    if (it < 128) {
                        const int rb = it & 7, gg = (it >> 3) & 1, b = (it >> 4) & 3, tensor = it >> 6;
                        SK_CMP(compress_item)(PROJ, args.in[tensor ? 12 : 9] + (size_t)eo * 32 * 128, (const bf16_t*)(ws + (tensor ? WS_W1V : WS_W1K) + eo * MiB),
                                      (const bf16_t*)(ws + (tensor ? WS_W2V : WS_W2K) + eo * 32768), (bf16_t*)(ws + (tensor ? WS_VC : WS_KC)) + (size_t)(b * 2 + gg) * 256 * 128,
                                      b, gg, rb, tensor ? 4352 : 4096, lds, tid);
                    } else {
                        const int u = it - 128; SK_MPREP(moba_prep_item)(PROJ, (float*)(ws + WS_KMEAN), u >> 7, (u >> 4) & 7, u & 15, lds, tid);
                    }
                }
            }
            SEAM(pb + 1);
            if (IN(pb + 2)) {
                for (int rep = 0; rep < DUPN(2); ++rep) {
                PHASE_VARS
                unsigned* qh = (unsigned*)(ws + WS_CTL) + CW_QUEUE + 128 * eo + 32 * rep;
                bool second_ = true;
                bool first_ = true;
                for (;;) {
                    unsigned idx;
                    if (first_) { idx = (unsigned)bid; first_ = false; }
                    else if (G == 256) { if (second_) { idx = 511u - (unsigned)bid; second_ = false; } else idx = 512u; }
                    else {
                        __syncthreads();
                        if (tid == 0) MISC[16] = (unsigned)G + __hip_atomic_fetch_add(qh, 1u, __ATOMIC_RELAXED, __HIP_MEMORY_SCOPE_AGENT);
                        __syncthreads();
                        idx = MISC[16];
                    }
                    if (idx >= 512u) break;
                    SK_NSA(nsa_unit)((const bf16_t*)(ws + WS_R1), (const bf16_t*)(ws + WS_NQROT), (const bf16_t*)(ws + WS_KC), (const bf16_t*)(ws + WS_VC), (bf16_t*)(ws + WS_ATT), (int)(idx & 7u) >> 1, (int)(idx & 1u), 63 - (int)(idx >> 3), lds, tid);
                }
                }
                for (int rep = 0; rep < DUPN(8); ++rep) {
                PHASE_VARS
                unsigned* qh = (unsigned*)(ws + WS_CTL) + CW_QUEUE + 128 * eo + 64 + 32 * rep;
                bool second_ = true;
                bool first_ = true;
                for (;;) {
                    unsigned idx;
                    if (first_) { idx = (G == 256) ? (unsigned)(((bid >> 3) & 15) * 32 + 4 * (bid & 7) + (bid >> 7)) : (unsigned)bid; first_ = false; }
                    else if (G == 256) { if (second_) { idx = (unsigned)((15 - ((bid >> 3) & 15)) * 32 + 4 * (bid & 7) + 2 + (bid >> 7)); second_ = false; } else idx = 512u; }
                    else {
                        __syncthreads();
                        if (tid == 0) MISC[17] = (unsigned)G + __hip_atomic_fetch_add(qh, 1u, __ATOMIC_RELAXED, __HIP_MEMORY_SCOPE_AGENT);
                        __syncthreads();
                        idx = MISC[17];
                    }
                    if (idx >= 512u) break;
                    SK_MOBA(moba_unit)((const bf16_t*)(ws + WS_R1), (const float*)(ws + WS_KMEAN), (bf16_t*)(ws + WS_ATT), (int)(idx & 31u) >> 3, (int)(idx & 7u), 15 - (int)(idx >> 5), lds, tid);
                }
                }
            }
            SEAM(pb + 2);
        } else {
            if (IN(pb + 1)) {
                PHASE_VARS
                for (int rep = 0; rep < DUPN(3); ++rep) for (int u = bid; u < 256; u += G) { const int bh = (u & 7) + 8 * (u >> 6), vs = (u >> 3) & 7; SK_RET(retention_unit)((const bf16_t*)(ws + WS_R1), (bf16_t*)(ws + WS_Y), bh >> 3, bh & 7, vs, lds, tid); }
            }
            SEAM(pb + 1);
            if (IN(pb + 2)) { PHASE_VARS SK_GN(phase_gn_gate)((bf16_t*)(ws + WS_Y), (const bf16_t*)(ws + WS_R1), args.in[17] + (size_t)eo * 8 * 512, gw, ngw, lane); }
            SEAM(pb + 2);
        }
        if (IN(pb + 3)) {
            PHASE_VARS
            const int K = odd ? 4096 : 2048;
            const bf16_t* A = odd ? (const bf16_t*)(ws + WS_Y) : (const bf16_t*)(ws + WS_ATT);
            const bf16_t* Wt = odd ? (const bf16_t*)(ws + WS_WOUTC + eo * 16 * MiB) : (const bf16_t*)(ws + WS_WOUTAB + eo * 8 * MiB);
            pg8::Gemm g{A, Wt, M, 2048, K}; pg8::StaticOrder S; S.init(M, 2048, G, bid);
            pg8::EpiResid3 E{(bf16_t*)(ws + WS_HN), (float*)(ws + WS_SSP), M, (LAS float*)(lds + EPI_SCR_OFF), D};
            SK_GEMM pg8::gemm_phase<pg8::EpiResid3, pg8::StaticOrder, true, true>(lds, g, S, E, tid);
        }
        SEAM(pb + 3);
        if (IN(pb + 4)) {
            PHASE_VARS
            pg8::Gemm g{(const bf16_t*)(ws + WS_HN), (const bf16_t*)(ws + WS_WQX + layer * 2 * MiB), M, 512, 2048}; pg8::StaticOrder S; S.init(M, 512, G, bid);
            pg8::EpiStoreN E{(bf16_t*)(ws + WS_QX), 512, (const float*)(ws + WS_SSP), M, nullptr, 0, nullptr};
            for (int rep = 0; rep < DUPN(6); ++rep) SK_GEMM pg8::gemm_phase<pg8::EpiStoreN, pg8::StaticOrder, true, true>(lds, g, S, E, tid);
            if (layer + 1 < DEPTH) {
                const int c0 = (G > 128) ? 128 : 0;
                if (bid >= c0) {
                    __syncthreads();
                    LAS float* scr = (LAS float*)(lds + wave * 16640); int base = 0;
                    transpose_matrix(args.in[25] + (size_t)(layer + 1) * DFF * 2048, nullptr, DFF, 2048, 2048, (bf16_t*)(ws + WS_WDOWN + (layer + 1) * 22 * MiB), scr, (bid - c0) * NWAVES + wave, (G - c0) * NWAVES, lane, base);
                }
            }
        }
        SEAM(pb + 4);
        if (IN(pb + 5)) {
            PHASE_VARS
            for (int rep = 0; rep < DUPN(5); ++rep) for (int u = bid; u < 256; u += G) SK_CROSS(cross_unit)((const bf16_t*)(ws + WS_QX), (const bf16_t*)(ws + WS_MEMKV), (bf16_t*)(ws + WS_AX), layer, u >> 6, (u >> 4) & 3, u & 15, lds, tid);
        }
        SEAM(pb + 5);
        if (IN(pb + 6)) {
            PHASE_VARS
            pg8::Gemm g{(const bf16_t*)(ws + WS_AX), (const bf16_t*)(ws + WS_WOX + layer * 2 * MiB), M, 2048, 512}; pg8::StaticOrder S; S.init(M, 2048, G, bid);
            pg8::EpiResid3 E{(bf16_t*)(ws + WS_HN), (float*)(ws + WS_SSP), M, (LAS float*)(lds + EPI_SCR_OFF), D};
            SK_GEMM pg8::gemm_phase<pg8::EpiResid3, pg8::StaticOrder, true, true>(lds, g, S, E, tid);
        }
        SEAM(pb + 6);
        if (IN(pb + 7)) {
            PHASE_VARS
            pg8::Gemm g{(const bf16_t*)(ws + WS_HN), (const bf16_t*)(ws + WS_WUP + layer * 44 * MiB), M, DFF2, 2048}; pg8::StaticOrder S; S.init(M, DFF2, G, bid);
            pg8::EpiStoreFFN E{(bf16_t*)(ws + WS_ACT), (const float*)(ws + WS_SSP), M, args.in[23] + (size_t)layer * 3 * DFF2, args.in[24] + (size_t)layer * DFF2, (bf16_t*)(ws + WS_R1), (LAS float*)(lds + EPI_SCR_OFF)};
            for (int rep = 0; rep < DUPN(6); ++rep) SK_GEMM pg8::gemm_phase<pg8::EpiStoreFFN, pg8::StaticOrder, true, true>(lds, g, S, E, tid);
        }
        SEAM(pb + 7);
        if (IN(pb + 8)) { PHASE_VARS for (int rep = 0; rep < DUPN(1); ++rep) SK_CONV(phase_conv_fixup)((const bf16_t*)(ws + WS_R1), args.in[23] + (size_t)layer * 3 * DFF2, args.in[24] + (size_t)layer * DFF2, (bf16_t*)(ws + WS_ACT), gtid, ngt); }
        SEAM(pb + 8);
        if (IN(pb + 9)) {
            PHASE_VARS
            pg8::Gemm g{(const bf16_t*)(ws + WS_ACT), (const bf16_t*)(ws + WS_WDOWN + layer * 22 * MiB), M, 2048, DFF}; pg8::StaticOrder S; S.init(M, 2048, G, bid);
            pg8::EpiResid3 E{(bf16_t*)(ws + WS_HN), (float*)(ws + WS_SSP), M, (LAS float*)(lds + EPI_SCR_OFF), D};
            SK_GEMM pg8::gemm_phase<pg8::EpiResid3, pg8::StaticOrder, true, true>(lds, g, S, E, tid);
        }
        SEAM(pb + 9);
    }
    if (IN(PH_FINAL)) { PHASE_VARS for (int m = gw; m < M; m += ngw) rms_row_bf16in_f32((const bf16_t*)(ws + WS_HN) + (size_t)m * D, args.in[7], args.out + (size_t)m * D, lane); }
#undef IN
#undef SEAM
#undef PHASE_VARS
}

#ifndef MK_PER_PHASE
#define MK_PER_PHASE 0
#endif
extern "C" void kernel_launch(void* const* d_in, const int* in_sizes, int n_in, void* d_out, int out_size, void* d_ws, size_t ws_size, hipStream_t stream) {
    static int grid = 0;
    if (grid == 0) {
        if (n_in != 26 || in_sizes[0] != M * D || out_size != M * D || ws_size < WS_END) {
            fprintf(stderr, "kernel_launch: unexpected shapes: n_in %d in0 %d out %d ws %zu (need %zu); nothing launched\n", n_in, n_in > 0 ? in_sizes[0] : -1, out_size, ws_size, (size_t)WS_END); grid = -1; return; }
        int dev = 0, cus = 0, per_cu = 0;
        if (hipGetDevice(&dev) != hipSuccess || hipDeviceGetAttribute(&cus, hipDeviceAttributeMultiprocessorCount, dev) != hipSuccess) { fprintf(stderr, "kernel_launch: device query failed\n"); grid = -1; return; }
        if (hipFuncSetAttribute((const void*)fwd_kernel, hipFuncAttributeMaxDynamicSharedMemorySize, LDS_BYTES) != hipSuccess) { fprintf(stderr, "kernel_launch: hipFuncSetAttribute(%d B LDS) failed\n", LDS_BYTES); grid = -1; return; }
        if (hipOccupancyMaxActiveBlocksPerMultiprocessor(&per_cu, (const void*)fwd_kernel, NTHREADS, LDS_BYTES) != hipSuccess || per_cu < 1)
            fprintf(stderr, "kernel_launch: note: occupancy query reports %d workgroups per CU\n", per_cu);
        (void)hipGetLastError();
        grid = cus;
    }
    if (grid < 0) return;
    if (hipMemsetAsync((char*)d_ws + WS_CTL, 0, CTL_ZERO_BYTES, stream) != hipSuccess) { fprintf(stderr, "kernel_launch: memset failed\n"); return; }
    Args a{};
    for (int i = 0; i < 26; ++i) a.in[i] = (const float*)d_in[i];
    a.out = (float*)d_out; a.ws = (unsigned char*)d_ws;
#if MK_PER_PHASE
    for (int p = 0; p < N_PHASES; ++p) { a.ph_lo = p; a.ph_hi = p + 1; hipLaunchKernelGGL(fwd_kernel, dim3(grid), dim3(NTHREADS), LDS_BYTES, stream, a); }
#else
    a.ph_lo = 0; a.ph_hi = N_PHASES; hipLaunchKernelGGL(fwd_kernel, dim3(grid), dim3(NTHREADS), LDS_BYTES, stream, a);
#endif
    const hipError_t le = hipPeekAtLastError();
    if (le != hipSuccess) fprintf(stderr, "kernel_launch: launch failed: %s\n", hipGetErrorName(le));
}
```
